# Optimizing an MI355X kernel written in HIP

```python
import jax, jax.numpy as jnp
from jax import lax
import numpy as np

D_MODEL = 1024
BATCH = 8
SEQ = 2048
DEPTH = 2

ROPE_THETA = 500000.0
Q_BLOCK = 128
NEG_INF = -1e30
NORM_EPS = 1e-6
POS_OFFSET_MAX = 512
HEAD_DIM = 64
PARTIAL_ROT = HEAD_DIM // 4
N_BRANCH = 4
BRANCH_W = 4 * HEAD_DIM
D_FF = 4 * D_MODEL

MLA_HEADS = 4
MLA_NOPE = 64
MLA_ROPE = 32
MLA_V = 64
MLA_Q_LORA = 256
MLA_KV_LORA = 128

NSA_HEADS = 4
NSA_CMP_LEN = 32
NSA_CMP_STRIDE = 16
NSA_SEL_LEN = 64
NSA_TOP_N = 8
NSA_WINDOW = 512
NSA_N_PATHS = 3
NSA_FORCED_SCORE = 1e4

FOX_HEADS = 4

DSA_HEADS = 4
IDX_HEADS = 8
IDX_DIM = 32
IDX_ROT = IDX_DIM // 4
DSA_TOP_K = 256
DSA_KEEP_DIV = 4

MLA_COLS = MLA_Q_LORA + MLA_KV_LORA + MLA_ROPE
NSA_COLS = NSA_HEADS * HEAD_DIM + 6 * HEAD_DIM + NSA_N_PATHS * NSA_HEADS
FOX_COLS = 3 * FOX_HEADS * HEAD_DIM + FOX_HEADS
DSA_COLS = DSA_HEADS * HEAD_DIM + 2 * HEAD_DIM + IDX_HEADS * IDX_DIM + IDX_DIM + IDX_HEADS
GATE_COLS = N_BRANCH * D_MODEL
IN_COLS = MLA_COLS + NSA_COLS + FOX_COLS + DSA_COLS + GATE_COLS

kernel_name = "hybrid_mla_nsa_fox_dsa_gated_block"


def split_cols(z, sizes):
    cuts = [int(c) for c in np.cumsum(sizes)[:-1]]
    return jnp.split(z, cuts, axis=-1)


def rmsnorm(x, g):
    xf = x.astype(jnp.float32)
    y = xf * lax.rsqrt(jnp.mean(xf * xf, axis=-1, keepdims=True) + NORM_EPS)
    return (y * g.astype(jnp.float32)).astype(x.dtype)


def rope_tables(positions, rot_dim):
    inv = ROPE_THETA ** (-jnp.arange(0, rot_dim, 2, dtype=jnp.float32) / rot_dim)
    ang = positions.astype(jnp.float32)[..., None] * inv
    return (jnp.cos(ang), jnp.sin(ang))


def apply_rope(x, rope):
    cos, sin = rope
    half = cos.shape[-1]
    if x.ndim == 4:
        cos, sin = cos[:, :, None, :], sin[:, :, None, :]
    cos, sin = cos.astype(x.dtype), sin.astype(x.dtype)
    x1, x2 = x[..., :half], x[..., half:2 * half]
    return jnp.concatenate([x1 * cos - x2 * sin, x2 * cos + x1 * sin, x[..., 2 * half:]], axis=-1)


def masked_softmax(s, mask):
    s = jnp.where(mask, s, NEG_INF)
    m = jnp.max(s, axis=-1, keepdims=True)
    p = jnp.exp(s - m) * mask
    return p / jnp.maximum(jnp.sum(p, axis=-1, keepdims=True), 1e-30)


def sweep_query_blocks(fn, seq):
    out = lax.map(fn, jnp.arange(seq // Q_BLOCK))
    out = jnp.moveaxis(out, 0, 1)
    return out.reshape((out.shape[0], seq) + out.shape[3:])


def blocked_causal_attention(q, k, v, scale, decay=None):
    S = q.shape[1]
    key_pos = jnp.arange(S)
    decay_t = None if decay is None else jnp.swapaxes(decay, 1, 2)

    def one_block(i):
        start = i * Q_BLOCK
        qb = lax.dynamic_slice_in_dim(q, start, Q_BLOCK, axis=1)
        s = jnp.einsum('bqhd,bkhd->bhqk', qb, k).astype(jnp.float32) * scale
        if decay_t is not None:
            cq = lax.dynamic_slice_in_dim(decay_t, start, Q_BLOCK, axis=2)
            s = s + (cq[..., :, None] - decay_t[..., None, :])
        q_pos = start + jnp.arange(Q_BLOCK)
        mask = key_pos[None, :] <= q_pos[:, None]
        p = jax.nn.softmax(jnp.where(mask, s, NEG_INF), axis=-1)
        return jnp.einsum('bhqk,bkhd->bqhd', p.astype(v.dtype), v)

    return sweep_query_blocks(one_block, S)


def mla_mixer(z, q_norm_g, w_uq, kv_norm_g, w_ukv, rope):
    B, S, _ = z.shape
    H = MLA_HEADS
    c_q, c_kv, k_rope = split_cols(z, [MLA_Q_LORA, MLA_KV_LORA, MLA_ROPE])
    q = (rmsnorm(c_q, q_norm_g) @ w_uq).reshape(B, S, H, MLA_NOPE + MLA_ROPE)
    q = jnp.concatenate([q[..., :MLA_NOPE], apply_rope(q[..., MLA_NOPE:], rope)], axis=-1)
    kv = (rmsnorm(c_kv, kv_norm_g) @ w_ukv).reshape(B, S, H, MLA_NOPE + MLA_V)
    k_rope = apply_rope(k_rope, rope)
    k = jnp.concatenate([kv[..., :MLA_NOPE],
                         jnp.broadcast_to(k_rope[:, :, None, :], (B, S, H, MLA_ROPE))], axis=-1)
    v = kv[..., MLA_NOPE:]
    o = blocked_causal_attention(q, k, v, (MLA_NOPE + MLA_ROPE) ** -0.5)
    return o.reshape(B, S, H * MLA_V)


def nsa_mixer(z, cmp_w, cmp_pe, rope):
    B, S, _ = z.shape
    H, D = NSA_HEADS, HEAD_DIM
    q, kc, vc, ks, vs, kw, vw, g = split_cols(z, [H * D] + [D] * 6 + [NSA_N_PATHS * H])
    q = apply_rope(q.reshape(B, S, H, D), rope)
    kc, ks, kw = apply_rope(kc, rope), apply_rope(ks, rope), apply_rope(kw, rope)
    g = jax.nn.sigmoid(g.reshape(B, S, NSA_N_PATHS, H))
    scale = D ** -0.5
    t_pos = jnp.arange(S)
    bidx = jnp.arange(B)[:, None, None]

    n_cmp = (S - NSA_CMP_LEN) // NSA_CMP_STRIDE + 1
    cmp_start = jnp.arange(n_cmp) * NSA_CMP_STRIDE
    win_idx = cmp_start[:, None] + jnp.arange(NSA_CMP_LEN)[None, :]

    def compress(t, w, pe):
        blocks = t[:, win_idx] + pe
        return blocks.reshape(B, n_cmp, NSA_CMP_LEN * D) @ w

    k_cmp = compress(kc, cmp_w[0], cmp_pe[0])
    v_cmp = compress(vc, cmp_w[1], cmp_pe[1])
    cmp_mask = (cmp_start + NSA_CMP_LEN - 1)[None, :] <= t_pos[:, None]
    s_cmp = jnp.einsum('bthd,bcd->bhtc', q, k_cmp).astype(jnp.float32) * scale
    p_cmp = masked_softmax(s_cmp, cmp_mask)
    o_cmp = jnp.einsum('bhtc,bcd->bthd', p_cmp.astype(v_cmp.dtype), v_cmp)

    n_sb = S // NSA_SEL_LEN
    sb = jnp.arange(n_sb)
    sb_start = sb * NSA_SEL_LEN
    overlap = jnp.maximum(
        jnp.minimum(cmp_start[:, None] + NSA_CMP_LEN, sb_start[None, :] + NSA_SEL_LEN)
        - jnp.maximum(cmp_start[:, None], sb_start[None, :]), 0).astype(jnp.float32) / NSA_CMP_LEN
    imp = jnp.einsum('bhtc,cj->btj', p_cmp, overlap)
    t_blk = t_pos[:, None] // NSA_SEL_LEN
    forced = (sb[None, :] == 0) | (sb[None, :] == t_blk) | (sb[None, :] == t_blk - 1)
    imp = jnp.where(forced, NSA_FORCED_SCORE, imp)
    imp = jnp.where(sb_start[None, :] <= t_pos[:, None], imp, NEG_INF)
    n_top = min(NSA_TOP_N, n_sb)
    _, sel_idx = lax.top_k(imp, n_top)
    k_blk = ks.reshape(B, n_sb, NSA_SEL_LEN, D)
    v_blk = vs.reshape(B, n_sb, NSA_SEL_LEN, D)

    def sel_block(i):
        start = i * Q_BLOCK
        qb = lax.dynamic_slice_in_dim(q, start, Q_BLOCK, axis=1)
        ib = lax.dynamic_slice_in_dim(sel_idx, start, Q_BLOCK, axis=1)
        kg = k_blk[bidx, ib].reshape(B, Q_BLOCK, n_top * NSA_SEL_LEN, D)
        vg = v_blk[bidx, ib].reshape(B, Q_BLOCK, n_top * NSA_SEL_LEN, D)
        qp = start + jnp.arange(Q_BLOCK)
        kpos = (ib[..., None] * NSA_SEL_LEN + jnp.arange(NSA_SEL_LEN)).reshape(B, Q_BLOCK, -1)
        mask = kpos <= qp[None, :, None]
        s = jnp.einsum('bqhd,bqmd->bhqm', qb, kg).astype(jnp.float32) * scale
        p = masked_softmax(s, mask[:, None])
        return jnp.einsum('bhqm,bqmd->bqhd', p.astype(vg.dtype), vg)

    o_sel = sweep_query_blocks(sel_block, S)

    kpad = jnp.pad(kw, ((0, 0), (NSA_WINDOW, 0), (0, 0)))
    vpad = jnp.pad(vw, ((0, 0), (NSA_WINDOW, 0), (0, 0)))

    def win_block(i):
        start = i * Q_BLOCK
        qb = lax.dynamic_slice_in_dim(q, start, Q_BLOCK, axis=1)
        kb = lax.dynamic_slice_in_dim(kpad, start, NSA_WINDOW + Q_BLOCK, axis=1)
        vb = lax.dynamic_slice_in_dim(vpad, start, NSA_WINDOW + Q_BLOCK, axis=1)
        kpos = start - NSA_WINDOW + jnp.arange(NSA_WINDOW + Q_BLOCK)
        qp = start + jnp.arange(Q_BLOCK)
        mask = ((kpos[None, :] <= qp[:, None]) & (kpos[None, :] > qp[:, None] - NSA_WINDOW)
                & (kpos[None, :] >= 0))
        s = jnp.einsum('bqhd,bkd->bhqk', qb, kb).astype(jnp.float32) * scale
        p = masked_softmax(s, mask)
        return jnp.einsum('bhqk,bkd->bqhd', p.astype(vb.dtype), vb)

    o_win = sweep_query_blocks(win_block, S)

    o = (g[:, :, 0, :, None] * o_cmp + g[:, :, 1, :, None] * o_sel
         + g[:, :, 2, :, None] * o_win)
    return o.reshape(B, S, H * D)


def fox_mixer(z, f_bias):
    B, S, _ = z.shape
    H, D = FOX_HEADS, HEAD_DIM
    q, k, v, f = split_cols(z, [H * D, H * D, H * D, H])
    log_f = jax.nn.log_sigmoid((f + f_bias).astype(jnp.float32))
    c = jnp.cumsum(log_f, axis=1)
    o = blocked_causal_attention(q.reshape(B, S, H, D), k.reshape(B, S, H, D),
                                 v.reshape(B, S, H, D), D ** -0.5, decay=c)
    return o.reshape(B, S, H * D)


def dsa_mixer(z, rope_head, rope_idx):
    B, S, _ = z.shape
    H, D = DSA_HEADS, HEAD_DIM
    q, k, v, qi, ki, w = split_cols(z, [H * D, D, D, IDX_HEADS * IDX_DIM, IDX_DIM, IDX_HEADS])
    q = apply_rope(q.reshape(B, S, H, D), rope_head)
    k = apply_rope(k, rope_head)
    qi = apply_rope(qi.reshape(B, S, IDX_HEADS, IDX_DIM), rope_idx)
    ki = apply_rope(ki, rope_idx)
    n_keep = min(DSA_TOP_K, S // DSA_KEEP_DIV)
    scale = D ** -0.5
    key_pos = jnp.arange(S)
    bidx = jnp.arange(B)[:, None, None]

    def one_block(i):
        start = i * Q_BLOCK
        qb = lax.dynamic_slice_in_dim(q, start, Q_BLOCK, axis=1)
        qib = lax.dynamic_slice_in_dim(qi, start, Q_BLOCK, axis=1)
        wb = lax.dynamic_slice_in_dim(w, start, Q_BLOCK, axis=1).astype(jnp.float32)
        logits = jnp.einsum('bqhd,bkd->bqhk', qib, ki).astype(jnp.float32) * IDX_DIM ** -0.5
        score = jnp.einsum('bqhk,bqh->bqk', jax.nn.relu(logits), wb) * IDX_HEADS ** -0.5
        qp = start + jnp.arange(Q_BLOCK)
        score = jnp.where(key_pos[None, None, :] <= qp[None, :, None], score, NEG_INF)
        _, idx = lax.top_k(score, n_keep)
        kg = k[bidx, idx]
        vg = v[bidx, idx]
        s = jnp.einsum('bqhd,bqkd->bhqk', qb, kg).astype(jnp.float32) * scale
        valid = idx <= qp[None, :, None]
        p = masked_softmax(s, valid[:, None])
        return jnp.einsum('bhqk,bqkd->bqhd', p.astype(vg.dtype), vg)

    o = sweep_query_blocks(one_block, S)
    return o.reshape(B, S, H * D)


def setup_inputs(seed: int = 0) -> dict:
    key = jax.random.key(seed)
    ks = jax.random.split(key, 18)

    def nrm(k, shape, fan_in):
        return jax.random.normal(k, shape, jnp.float32) * fan_in ** -0.5

    def gain(k, shape):
        return 1.0 + 0.02 * jax.random.normal(k, shape, jnp.float32)

    x = jax.random.normal(ks[0], (BATCH, SEQ, D_MODEL), jnp.float32)
    offset = jax.random.randint(ks[1], (BATCH, 1), 0, POS_OFFSET_MAX, dtype=jnp.int32)
    positions = offset + jnp.arange(SEQ, dtype=jnp.int32)[None, :]
    return {
        "x": x,
        "positions": positions,
        "norm1_g": gain(ks[2], (DEPTH, D_MODEL)),
        "w_in": nrm(ks[3], (DEPTH, D_MODEL, IN_COLS), D_MODEL),
        "mla_q_norm_g": gain(ks[4], (DEPTH, MLA_Q_LORA)),
        "mla_w_uq": nrm(ks[5], (DEPTH, MLA_Q_LORA, MLA_HEADS * (MLA_NOPE + MLA_ROPE)), MLA_Q_LORA),
        "mla_kv_norm_g": gain(ks[6], (DEPTH, MLA_KV_LORA)),
        "mla_w_ukv": nrm(ks[7], (DEPTH, MLA_KV_LORA, MLA_HEADS * (MLA_NOPE + MLA_V)), MLA_KV_LORA),
        "nsa_cmp_pe": 0.1 * jax.random.normal(ks[8], (DEPTH, 2, NSA_CMP_LEN, HEAD_DIM), jnp.float32),
        "nsa_cmp_w": nrm(ks[9], (DEPTH, 2, NSA_CMP_LEN * HEAD_DIM, HEAD_DIM), NSA_CMP_LEN * HEAD_DIM),
        "fox_f_bias": 1.0 + 0.1 * jax.random.normal(ks[10], (DEPTH, FOX_HEADS), jnp.float32),
        "w_branch": nrm(ks[11], (DEPTH, N_BRANCH, BRANCH_W, D_MODEL), BRANCH_W),
        "w_out": nrm(ks[12], (DEPTH, D_MODEL, D_MODEL), D_MODEL),
        "norm2_g": gain(ks[13], (DEPTH, D_MODEL)),
        "w_up": nrm(ks[14], (DEPTH, D_MODEL, D_FF), D_MODEL),
        "w_down": nrm(ks[15], (DEPTH, D_FF, D_MODEL), D_FF),
        "final_g": gain(ks[16], (D_MODEL,)),
    }


def reference(x, positions, norm1_g, w_in, mla_q_norm_g, mla_w_uq, mla_kv_norm_g, mla_w_ukv,
              nsa_cmp_pe, nsa_cmp_w, fox_f_bias, w_branch, w_out, norm2_g, w_up, w_down, final_g):
    B, S, _ = x.shape
    rope_mla = rope_tables(positions, MLA_ROPE)
    rope_head = rope_tables(positions, PARTIAL_ROT)
    rope_idx = rope_tables(positions, IDX_ROT)
    for l in range(DEPTH):
        h = rmsnorm(x, norm1_g[l])
        z = h @ w_in[l]
        z_mla, z_nsa, z_fox, z_dsa, z_gate = split_cols(
            z, [MLA_COLS, NSA_COLS, FOX_COLS, DSA_COLS, GATE_COLS])
        o_mla = mla_mixer(z_mla, mla_q_norm_g[l], mla_w_uq[l], mla_kv_norm_g[l], mla_w_ukv[l], rope_mla)
        o_nsa = nsa_mixer(z_nsa, nsa_cmp_w[l], nsa_cmp_pe[l], rope_head)
        o_fox = fox_mixer(z_fox, fox_f_bias[l])
        o_dsa = dsa_mixer(z_dsa, rope_head, rope_idx)
        branches = jnp.stack([o_mla, o_nsa, o_fox, o_dsa], axis=2)
        lifted = jnp.einsum('bsnc,ncd->bsnd', branches, w_branch[l])
        gates = jax.nn.sigmoid(z_gate.reshape(B, S, N_BRANCH, D_MODEL))
        mixed = jnp.sum(gates * lifted, axis=2)
        x = x + mixed @ w_out[l]
        h2 = rmsnorm(x, norm2_g[l])
        x = x + jnp.square(jax.nn.relu(h2 @ w_up[l])) @ w_down[l]
    return rmsnorm(x, final_g)
```

```cpp
#include <hip/hip_runtime.h>
#include <hip/hip_cooperative_groups.h>
#include <cstdio>
#include <cstdint>
namespace cg = cooperative_groups;

#define LAS __attribute__((address_space(3)))
typedef unsigned short bf16_t;
typedef short bf16x8 __attribute__((ext_vector_type(8)));
typedef float f32x4 __attribute__((ext_vector_type(4)));
typedef float f32x16 __attribute__((ext_vector_type(16)));
typedef unsigned u32x4 __attribute__((ext_vector_type(4)));
typedef unsigned u32x2 __attribute__((ext_vector_type(2)));

constexpr int DM = 1024, NB = 8, SEQ = 2048, NTOK = NB * SEQ, DFF = 4096, INC = 6616, ZW = 2560, DEPTH = 2;
constexpr int ZC_CQ = 0, ZC_CKV = 256, ZC_KR = 384, ZC_NQ = 416, ZC_NKC = 672, ZC_NVC = 736, ZC_NKS = 800, ZC_NVS = 864, ZC_NKW = 928, ZC_NVW = 992,
              ZC_FQ = 1056, ZC_FK = 1312, ZC_FV = 1568, ZC_DQ = 1824, ZC_DK = 2080, ZC_DV = 2144, ZC_DQI = 2208, ZC_DKI = 2464,
              ZC_NG = 2496, ZC_FF = 2508, ZC_DW = 2512;
constexpr float NORM_EPS = 1e-6f, NEGF = -1e30f, LOG2E = 1.4426950408889634f;

constexpr size_t MiB = 1u << 20;
constexpr size_t WS_CTL = 0;
constexpr size_t WS_WZ = 1 * MiB, WS_WG = 6 * MiB, WS_WMLA = 14 * MiB, WS_WCMP = 15 * MiB, WS_WBR = 17 * MiB, WS_WOUT4 = 19 * MiB, WS_WUP = 27 * MiB, WS_WDN = 35 * MiB;
constexpr size_t WS_WBR2 = 246 * MiB;
constexpr size_t WS_FOXC = 43 * MiB, WS_KCMP = 43 * MiB + 256 * 1024, WS_VCMP = 43 * MiB + 512 * 1024, WS_CMPB = 43 * MiB + 768 * 1024;
constexpr size_t WS_KCC = 44 * MiB, WS_VCC = 46 * MiB + 256 * 1024;
constexpr size_t WS_SELM = 49 * MiB, WS_H = 53 * MiB, WS_O = 85 * MiB, WS_QKVM = 117 * MiB, WS_GATE = 117 * MiB, WS_HID = 117 * MiB, WS_Z = 149 * MiB;
constexpr size_t WS_END = 254 * MiB;

constexpr int LDS_BYTES = 147456;

__device__ __forceinline__ unsigned f2bf(float f) { unsigned u = __float_as_uint(f); return (u + 0x7fffu + ((u >> 16) & 1u)) >> 16; }
__device__ __forceinline__ unsigned pk2(float lo, float hi) { return f2bf(lo) | (f2bf(hi) << 16); }
__device__ __forceinline__ float bf2f(unsigned b) { return __uint_as_float(b << 16); }
__device__ __forceinline__ float bflo(unsigned w) { return __uint_as_float(w << 16); }
__device__ __forceinline__ float bfhi(unsigned w) { return __uint_as_float(w & 0xffff0000u); }
typedef float f32x2_t __attribute__((ext_vector_type(2))); typedef __bf16 bf16x2_t __attribute__((ext_vector_type(2)));
__device__ __forceinline__ unsigned cvt_pk_bf16(float lo, float hi) { f32x2_t v = {lo, hi}; bf16x2_t b = __builtin_convertvector(v, bf16x2_t); return __builtin_bit_cast(unsigned, b); }
__device__ __forceinline__ float wave_sum(float v) {
#pragma unroll
    for (int o = 1; o < 64; o <<= 1) v += __shfl_xor(v, o);
    return v;
}

__device__ __forceinline__ float xchg32(float v) { const unsigned u = __float_as_uint(v); const auto rr = __builtin_amdgcn_permlane32_swap(u, u, false, false); return __uint_as_float((threadIdx.x & 32) ? rr[0] : rr[1]); }
__device__ __forceinline__ unsigned wred_add(unsigned v) {
    v += (unsigned)__builtin_amdgcn_update_dpp(0, (int)v, 0x111, 0xf, 0xf, true);
    v += (unsigned)__builtin_amdgcn_update_dpp(0, (int)v, 0x112, 0xf, 0xf, true);
    v += (unsigned)__builtin_amdgcn_update_dpp(0, (int)v, 0x114, 0xf, 0xf, true);
    v += (unsigned)__builtin_amdgcn_update_dpp(0, (int)v, 0x118, 0xf, 0xf, true);
    v += (unsigned)__builtin_amdgcn_update_dpp(0, (int)v, 0x142, 0xa, 0xf, true);
    v += (unsigned)__builtin_amdgcn_update_dpp(0, (int)v, 0x143, 0xc, 0xf, true);
    return (unsigned)__builtin_amdgcn_readlane((int)v, 63);
}
__device__ __forceinline__ unsigned wred_umax(unsigned v) {
    unsigned t;
    t = (unsigned)__builtin_amdgcn_update_dpp(0, (int)v, 0x111, 0xf, 0xf, true); v = t > v ? t : v;
    t = (unsigned)__builtin_amdgcn_update_dpp(0, (int)v, 0x112, 0xf, 0xf, true); v = t > v ? t : v;
    t = (unsigned)__builtin_amdgcn_update_dpp(0, (int)v, 0x114, 0xf, 0xf, true); v = t > v ? t : v;
    t = (unsigned)__builtin_amdgcn_update_dpp(0, (int)v, 0x118, 0xf, 0xf, true); v = t > v ? t : v;
    t = (unsigned)__builtin_amdgcn_update_dpp(0, (int)v, 0x142, 0xa, 0xf, true); v = t > v ? t : v;
    t = (unsigned)__builtin_amdgcn_update_dpp(0, (int)v, 0x143, 0xc, 0xf, true); v = t > v ? t : v;
    return (unsigned)__builtin_amdgcn_readlane((int)v, 63);
}
__device__ __forceinline__ float fmax1(float a, float b) { return __builtin_amdgcn_fmed3f(a, b, __builtin_inff()); }
#define LDS_WAIT() asm volatile("s_waitcnt lgkmcnt(0)" ::: "memory")

namespace pg8 {
constexpr int BM = 256, BK = 64, HALF = 128, HTB = HALF * BK * 2, STAGE_BYTES = 8 * HTB, NXCD = 8, WGM = 8;
__host__ __device__ __forceinline__ int lds_byte(int r, int c) { const int st = (r >> 4) * 2 + (c >> 5), rr = r & 15, cc = c & 31, ob = rr * 64 + cc * 2; return st * 1024 + (ob ^ (((ob >> 9) & 1) << 5)); }
__host__ __device__ __forceinline__ void stage_rc(int b, int& R, int& C) { const int st = b / 1024, sb = b % 1024, swz = sb ^ (((sb >> 9) & 1) << 5); R = (st >> 1) * 16 + swz / 64; C = (st & 1) * 32 + (swz % 64) / 2; }
__host__ __device__ __forceinline__ int perm32(int rho) { const int n = rho >> 4, i = rho & 15; return 8 * (i >> 2) + 4 * n + (i & 3); }

struct Unit { int pm, pn; int aoff; const char* A; const char* B; int nt; int kind; };
struct Gemm { const bf16_t* A; const bf16_t* Bt; int M, N, K, lda, ldb; };

struct StaticOrder {
    int nM, nN, nwg, G, c;
    __device__ void init(int M, int N, int G_, int c_) { nM = M / BM; nN = N / BM; nwg = nM * nN; G = G_; c = c_; }
    __device__ bool next(int i, Unit& u) const {
        const long L = (long)i * G + c; if (L >= nwg) return false;
        int wgid = (int)L; { const int q = nwg / NXCD, r = nwg % NXCD, xcd = wgid % NXCD, off = wgid / NXCD; wgid = (xcd < r ? xcd * (q + 1) : r * (q + 1) + (xcd - r) * q) + off; }
        const int nig = WGM * nN, gid = wgid / nig, fm = gid * WGM, gsz = (nM - fm) < WGM ? (nM - fm) : WGM;
        u.pm = fm + ((wgid % nig) % gsz); u.pn = (wgid % nig) / gsz; u.aoff = 0; u.nt = 0; u.kind = 0; u.A = nullptr; u.B = nullptr; return true;
    }
};

template <int ACT> struct EpiBf16 {
    static constexpr bool PERM = true;
    bf16_t* O; int ldc; int nvalid; const float* sq;
    __device__ __forceinline__ void operator()(const f32x4 (&acc)[2][2][4][2], const Unit& u, int wr, int wc, int fr, int fq) const {
        const int row0 = u.pm * BM + wr * 64 + fr; const int col0 = u.pn * BM + wc * 32 + 8 * fq;
#pragma unroll
        for (int ai = 0; ai < 2; ++ai)
#pragma unroll
            for (int m = 0; m < 4; ++m) { bf16_t* rowp = O + (size_t)(row0 + ai * HALF + m * 16) * ldc + col0;
                const float rs = sq ? 1.0f / sqrtf(sq[row0 + ai * HALF + m * 16] * (1.f / 1024.f) + NORM_EPS) : 1.f;
#pragma unroll
                for (int bj = 0; bj < 2; ++bj) { if (col0 + bj * HALF >= nvalid) continue;
                    f32x4 v0 = acc[ai][bj][m][0] * rs, v1 = acc[ai][bj][m][1] * rs;
                    if (ACT == 1) {
#pragma unroll
                        for (int j = 0; j < 4; ++j) { v0[j] = __builtin_amdgcn_rcpf(1.f + __expf(-v0[j])); v1[j] = __builtin_amdgcn_rcpf(1.f + __expf(-v1[j])); } }
                    if (ACT == 2) {
#pragma unroll
                        for (int j = 0; j < 4; ++j) { float a = fmaxf(v0[j], 0.f), b = fmaxf(v1[j], 0.f); v0[j] = a * a; v1[j] = b * b; } }
                    if (ACT == 3) { const u32x4 g = *(const u32x4*)(rowp + bj * HALF);
                        v0[0] *= bflo(g.x); v0[1] *= bfhi(g.x); v0[2] *= bflo(g.y); v0[3] *= bfhi(g.y);
                        v1[0] *= bflo(g.z); v1[1] *= bfhi(g.z); v1[2] *= bflo(g.w); v1[3] *= bfhi(g.w); }
                    u32x4 w; w.x = cvt_pk_bf16(v0[0], v0[1]); w.y = cvt_pk_bf16(v0[2], v0[3]); w.z = cvt_pk_bf16(v1[0], v1[1]); w.w = cvt_pk_bf16(v1[2], v1[3]);
                    *(u32x4*)(rowp + bj * HALF) = w; }
                asm volatile("" ::: "memory"); }
    }
};
struct EpiResid {
    static constexpr bool PERM = false;
    const float* base; float* out; int ldc; bf16_t* xb; float* sq;
    __device__ __forceinline__ void operator()(const f32x4 (&acc)[2][2][4][2], const Unit& u, int wr, int wc, int fr, int fq) const {
        const int col0 = u.pn * BM + wc * 32 + 4 * fq;
#pragma unroll
        for (int ai = 0; ai < 2; ++ai)
#pragma unroll
            for (int m = 0; m < 4; ++m) { const int row = u.pm * BM + ai * HALF + wr * 64 + m * 16 + fr; const size_t off = (size_t)row * ldc + col0;
                float ss = 0.f;
#pragma unroll
                for (int bj = 0; bj < 2; ++bj)
#pragma unroll
                    for (int n = 0; n < 2; ++n) { const f32x4 bs = *(const f32x4*)(base + off + bj * HALF + n * 16); const f32x4 v = bs + acc[ai][bj][m][n];
                        *(f32x4*)(out + off + bj * HALF + n * 16) = v;
                        u32x2 w; w.x = cvt_pk_bf16(v[0], v[1]); w.y = cvt_pk_bf16(v[2], v[3]); *(u32x2*)(xb + off + bj * HALF + n * 16) = w;
                        ss += (v[0] * v[0] + v[1] * v[1]) + (v[2] * v[2] + v[3] * v[3]); }
                ss += __shfl_xor(ss, 16); ss += __shfl_xor(ss, 32);
                if (fq == 0) atomicAdd(sq + row, ss);
                asm volatile("" ::: "memory"); }
    }
};
struct EpiCmp {
    static constexpr bool PERM = false;
    bf16_t* O; const float* bias;
    __device__ __forceinline__ void operator()(const f32x4 (&acc)[2][2][4][2], const Unit& u, int wr, int wc, int fr, int fq) const {
        if (u.pn != 0 || wc >= 2) return;
#pragma unroll
        for (int ai = 0; ai < 2; ++ai)
#pragma unroll
            for (int m = 0; m < 4; ++m) { const int row = u.pm * BM + ai * HALF + wr * 64 + m * 16 + fr;
#pragma unroll
                for (int n = 0; n < 2; ++n) { const int col = wc * 32 + n * 16 + 4 * fq; const f32x4 a = acc[ai][0][m][n];
                    float v[4];
#pragma unroll
                    for (int j = 0; j < 4; ++j) v[j] = ((row & 127) == 127) ? 0.f : a[j] + bias[col + j];
                    u32x2 w; w.x = pk2(v[0], v[1]); w.y = pk2(v[2], v[3]); *(u32x2*)(O + (size_t)row * 64 + col) = w; } }
    }
};


struct LiftOrder {
    StaticOrder so; int c;
    __device__ void init(int G_, int c_) { so.init(16384, 4096, G_, c_); c = c_; }
    __device__ bool next(int i, Unit& u) const { StaticOrder t = so; t.c = c; if (!t.next(i, u)) return false; u.aoff = (u.pn >> 2) * 512; return true; }
};
struct GroupOrder {
    int G, c;
    __device__ bool next(int i, Unit& u) const { const int grp = c + (i >> 2) * G; if (grp >= 256) return false; u.pm = grp >> 2; u.pn = (i & 3) * 4 + (grp & 3); u.aoff = 0; u.nt = 0; u.kind = 0; u.A = nullptr; u.B = nullptr; return true; }
};
__device__ __forceinline__ u32x4 load_sc(const bf16_t* p) { u32x4 v; asm volatile("global_load_dwordx4 %0, %1, off sc0 sc1\n\ts_waitcnt vmcnt(0)" : "=v"(v) : "v"(p) : "memory"); return v; }
struct EpiGateMix {
    static constexpr bool PERM = true;
    const bf16_t* L; bf16_t* MIX; const float* sq;
    __device__ __forceinline__ void operator()(const f32x4 (&acc)[2][2][4][2], const Unit& u, int wr, int wc, int fr, int fq) const {
        const int br = u.pn >> 2, pd = u.pn & 3;
        const int row0 = u.pm * BM + wr * 64 + fr; const int colL = u.pn * BM + wc * 32 + 8 * fq, colM = pd * BM + wc * 32 + 8 * fq;
#pragma unroll
        for (int ai = 0; ai < 2; ++ai)
#pragma unroll
            for (int m = 0; m < 4; ++m) { const size_t row = (size_t)(row0 + ai * HALF + m * 16);
                const float rs = 1.0f / sqrtf(sq[row] * (1.f / 1024.f) + NORM_EPS);
#pragma unroll
                for (int bj = 0; bj < 2; ++bj) {
                    const u32x4 g = *(const u32x4*)(L + row * 4096 + colL + bj * HALF);
                    f32x4 v0 = acc[ai][bj][m][0] * rs, v1 = acc[ai][bj][m][1] * rs;
#pragma unroll
                    for (int j = 0; j < 4; ++j) { v0[j] = __builtin_amdgcn_rcpf(1.f + __expf(-v0[j])); v1[j] = __builtin_amdgcn_rcpf(1.f + __expf(-v1[j])); }
                    v0[0] *= bflo(g.x); v0[1] *= bfhi(g.x); v0[2] *= bflo(g.y); v0[3] *= bfhi(g.y);
                    v1[0] *= bflo(g.z); v1[1] *= bfhi(g.z); v1[2] *= bflo(g.w); v1[3] *= bfhi(g.w);
                    bf16_t* mp = MIX + row * 1024 + colM + bj * HALF;
                    if (br > 0) { const u32x4 p = *(const u32x4*)mp;
                        v0[0] += bflo(p.x); v0[1] += bfhi(p.x); v0[2] += bflo(p.y); v0[3] += bfhi(p.y);
                        v1[0] += bflo(p.z); v1[1] += bfhi(p.z); v1[2] += bflo(p.w); v1[3] += bfhi(p.w); }
                    u32x4 w; w.x = cvt_pk_bf16(v0[0], v0[1]); w.y = cvt_pk_bf16(v0[2], v0[3]); w.z = cvt_pk_bf16(v1[0], v1[1]); w.w = cvt_pk_bf16(v1[2], v1[3]);
                    *(u32x4*)mp = w; }
                asm volatile("" ::: "memory"); }
    }
};


struct FusedOrder {
    int G, c; const char* Ob; const char* Wb; const char* Hb; const char* Wg;
    __device__ bool next(int i, Unit& u) const {
        const int grp = c + (i >> 3) * G; if (grp >= 256) return false;
        const int br = (i >> 1) & 3, pd = grp & 3; u.pm = grp >> 2; u.pn = br * 4 + pd; u.aoff = 0; u.kind = i & 1;
        if (u.kind == 0) { u.A = Ob + (size_t)u.pm * (256 * 1024 * 2) + br * 512; u.B = Wb + (size_t)u.pn * (256 * 1024 * 2); u.nt = 4; }
        else { u.A = Hb + (size_t)u.pm * (256 * 1024 * 2); u.B = Wg + (size_t)u.pn * (256 * 1024 * 2); u.nt = 16; }
        return true;
    }
};
struct EpiFused {
    static constexpr bool PERM = true;
    bf16_t* park; bf16_t* MIX; const float* sq;
    __device__ __forceinline__ void operator()(const f32x4 (&acc)[2][2][4][2], const Unit& u, int wr, int wc, int fr, int fq) const {
        const int br = u.pn >> 2, pd = u.pn & 3;
        const int rl0 = wr * 64 + fr, cl0 = wc * 32 + 8 * fq;
        const unsigned toff = (unsigned)(((wr * 4 + wc) * 64 + fq * 16 + fr) * 16);
        if (u.kind == 0) {
#pragma unroll
            for (int ai = 0; ai < 2; ++ai)
#pragma unroll
                for (int m = 0; m < 4; ++m) { char* pk2_ = (char*)park + toff; asm volatile("" : "+v"(pk2_));
#pragma unroll
                    for (int bj = 0; bj < 2; ++bj) { const f32x4 v0 = acc[ai][bj][m][0], v1 = acc[ai][bj][m][1];
                        u32x4 w; w.x = cvt_pk_bf16(v0[0], v0[1]); w.y = cvt_pk_bf16(v0[2], v0[3]); w.z = cvt_pk_bf16(v1[0], v1[1]); w.w = cvt_pk_bf16(v1[2], v1[3]);
                        *(u32x4*)(pk2_ + ((ai * 4 + m) * 2 + bj) * 8192) = w; }
                    asm volatile("" ::: "memory"); }
            return;
        }
#pragma unroll
        for (int ai = 0; ai < 2; ++ai)
#pragma unroll
            for (int m = 0; m < 4; ++m) { const int rl = rl0 + ai * HALF + m * 16; const size_t row = (size_t)(u.pm * BM + rl);
                const float rs = 1.0f / sqrtf(sq[row] * (1.f / 1024.f) + NORM_EPS);
                const char* pk2_ = (const char*)park + toff; asm volatile("" : "+v"(pk2_));
#pragma unroll
                for (int bj = 0; bj < 2; ++bj) {
                    const u32x4 g = *(const u32x4*)(pk2_ + ((ai * 4 + m) * 2 + bj) * 8192);
                    f32x4 v0 = acc[ai][bj][m][0] * rs, v1 = acc[ai][bj][m][1] * rs;
#pragma unroll
                    for (int j = 0; j < 4; ++j) { v0[j] = __builtin_amdgcn_rcpf(1.f + __expf(-v0[j])); v1[j] = __builtin_amdgcn_rcpf(1.f + __expf(-v1[j])); }
                    v0[0] *= bflo(g.x); v0[1] *= bfhi(g.x); v0[2] *= bflo(g.y); v0[3] *= bfhi(g.y);
                    v1[0] *= bflo(g.z); v1[1] *= bfhi(g.z); v1[2] *= bflo(g.w); v1[3] *= bfhi(g.w);
                    bf16_t* mp = MIX + row * 1024 + pd * BM + cl0 + bj * HALF;
                    if (br > 0) { const u32x4 p = *(const u32x4*)mp;
                        v0[0] += bflo(p.x); v0[1] += bfhi(p.x); v0[2] += bflo(p.y); v0[3] += bfhi(p.y);
                        v1[0] += bflo(p.z); v1[1] += bfhi(p.z); v1[2] += bflo(p.w); v1[3] += bfhi(p.w); }
                    u32x4 w; w.x = cvt_pk_bf16(v0[0], v0[1]); w.y = cvt_pk_bf16(v0[2], v0[3]); w.z = cvt_pk_bf16(v1[0], v1[1]); w.w = cvt_pk_bf16(v1[2], v1[3]);
                    *(u32x4*)mp = w; }
                asm volatile("" ::: "memory"); }
    }
};

template <class Epi, class Sched>
__device__ __forceinline__ void gemm_phase(LAS unsigned char* lds, const Gemm g, const Sched& S_in, const Epi& E) {
    int tid = threadIdx.x; asm volatile("" : "+v"(tid));
    const int wid = __builtin_amdgcn_readfirstlane(tid >> 6), lane = tid & 63, wr = wid >> 2, wc = wid & 3, fr = lane & 15, fq = lane >> 4;
    int K = g.K; asm volatile("" : "+s"(K)); const int nt_def = K / BK;
    unsigned voffA[2], voffB[2];
#pragma unroll
    for (int i = 0; i < 2; ++i) { int R, C; stage_rc(tid * 16 + i * 8192, R, C); const int Rb = Epi::PERM ? ((R & ~31) + perm32(R & 31)) : R;
        voffA[i] = (unsigned)(R * g.lda + C) * 2u; voffB[i] = (unsigned)(Rb * g.ldb + C) * 2u; }
    const size_t kstep = (size_t)(BK * 2);
    const size_t hsA = (size_t)HALF * g.lda * 2, hsB = (size_t)HALF * g.ldb * 2;
    const size_t tsA = 2 * hsA, tsB = 2 * hsB;
    const unsigned ldsw = (unsigned)wid * 1024u;
    const int aoff = lds_byte(wr * 64 + fr, fq * 8), boff = lds_byte(wc * 32 + fr, fq * 8);
#define PG8_SA(b, h) (((b) * 2 + (h)) * HTB)
#define PG8_SB(b, h) ((4 + (b) * 2 + (h)) * HTB)
#define PG8_STAGE(bufoff, gbase, voff) do { _Pragma("unroll") for (int _i = 0; _i < 2; ++_i) \
        __builtin_amdgcn_global_load_lds((const unsigned*)((const char*)(gbase) + (voff)[_i]), (LAS unsigned*)(lds + (bufoff) + ldsw + _i * 8192), 16, 0, 0); } while (0)
#define PG8_LDA(dst, b, h) do { _Pragma("unroll") for (int m = 0; m < 4; ++m) _Pragma("unroll") for (int k = 0; k < 2; ++k) dst[m][k] = *(const LAS bf16x8*)(lds + PG8_SA(b, h) + aoff + m * 2048 + k * 1024); } while (0)
#define PG8_LDB(dst, b, h) do { _Pragma("unroll") for (int n = 0; n < 2; ++n) _Pragma("unroll") for (int k = 0; k < 2; ++k) dst[n][k] = *(const LAS bf16x8*)(lds + PG8_SB(b, h) + boff + n * 2048 + k * 1024); } while (0)
#define PG8_MMA(ai, bj, At, Bt) do { __builtin_amdgcn_s_setprio(1); _Pragma("unroll") for (int m = 0; m < 4; ++m) _Pragma("unroll") for (int n = 0; n < 2; ++n) _Pragma("unroll") for (int k = 0; k < 2; ++k) \
        acc[ai][bj][m][n] = __builtin_amdgcn_mfma_f32_16x16x32_bf16(Bt[n][k], At[m][k], acc[ai][bj][m][n], 0, 0, 0); __builtin_amdgcn_s_setprio(0); } while (0)
#define PG8_WAIT_V(n) asm volatile("s_waitcnt vmcnt(" #n ")" ::: "memory")
#define PG8_WAIT_L(n) asm volatile("s_waitcnt lgkmcnt(" #n ")" ::: "memory")
#define PG8_BAR __builtin_amdgcn_s_barrier()
#define PG8_SCHED __builtin_amdgcn_sched_barrier(0)
    Sched S = S_in; asm volatile("" : "+s"(S.c));
    Unit cur, nxt; int ui = 0;
    if (!S.next(0, cur)) return;
#define PG8_RESOLVE(u) do { if ((u).nt == 0) { (u).A = (const char*)g.A + (size_t)(u).pm * tsA + (u).aoff; (u).B = (const char*)g.Bt + (size_t)(u).pn * tsB; (u).nt = nt_def; } } while (0)
    PG8_RESOLVE(cur);
    f32x4 acc[2][2][4][2];
#pragma unroll
    for (int a = 0; a < 2; ++a)
#pragma unroll
        for (int b = 0; b < 2; ++b)
#pragma unroll
            for (int m = 0; m < 4; ++m)
#pragma unroll
                for (int n = 0; n < 2; ++n) acc[a][b][m][n] = (f32x4){0.f, 0.f, 0.f, 0.f};
    bf16x8 At[4][2], B0[2][2], B1[2][2];
    const char* cA = cur.A; const char* cB = cur.B;
    {
        PG8_STAGE(PG8_SB(0, 0), cB, voffB); PG8_STAGE(PG8_SB(0, 1), cB + hsB, voffB); PG8_STAGE(PG8_SA(0, 0), cA, voffA); PG8_STAGE(PG8_SA(0, 1), cA + hsA, voffA);
        if (wr == 1) PG8_BAR;
        PG8_WAIT_V(2); PG8_BAR;
        PG8_STAGE(PG8_SB(1, 0), cB + kstep, voffB); PG8_STAGE(PG8_SA(1, 0), cA + kstep, voffA); PG8_STAGE(PG8_SB(1, 1), cB + hsB + kstep, voffB);
        PG8_WAIT_V(6); PG8_BAR;
    }
    for (;;) {
        const bool has_next = S.next(ui + 1, nxt);
        if (has_next) PG8_RESOLVE(nxt);
        const char* nA = has_next ? nxt.A : cA; const char* nB = has_next ? nxt.B : cB;
        const int nt = cur.nt;
        for (int t = 0; t < nt; t += 2) {
            const bool last = (t == nt - 2);
            const char* a1 = cA + (size_t)(t + 1) * kstep;
            const char* a2 = last ? nA : cA + (size_t)(t + 2) * kstep; const char* b2 = last ? nB : cB + (size_t)(t + 2) * kstep;
            const char* a3 = a2 + kstep; const char* b3 = b2 + kstep;
            PG8_LDB(B0, 0, 0); PG8_LDB(B1, 0, 1); PG8_SCHED; PG8_LDA(At, 0, 0); PG8_STAGE(PG8_SA(1, 1), a1 + hsA, voffA);
            PG8_WAIT_V(8); PG8_WAIT_L(0); PG8_BAR; PG8_MMA(0, 0, At, B0); PG8_MMA(0, 1, At, B1); PG8_BAR; PG8_SCHED;
            PG8_LDA(At, 0, 1); PG8_STAGE(PG8_SB(0, 0), b2, voffB); PG8_STAGE(PG8_SB(0, 1), b2 + hsB, voffB); PG8_STAGE(PG8_SA(0, 0), a2, voffA);
            PG8_WAIT_V(8); PG8_WAIT_L(0); PG8_BAR; PG8_MMA(1, 0, At, B0); PG8_MMA(1, 1, At, B1); PG8_BAR; PG8_SCHED;
            PG8_LDB(B0, 1, 0); PG8_LDB(B1, 1, 1); PG8_SCHED; PG8_LDA(At, 1, 0); PG8_STAGE(PG8_SA(0, 1), a2 + hsA, voffA);
            PG8_WAIT_V(8); PG8_WAIT_L(0); PG8_BAR; PG8_MMA(0, 0, At, B0); PG8_MMA(0, 1, At, B1); PG8_BAR; PG8_SCHED;
            PG8_LDA(At, 1, 1); PG8_STAGE(PG8_SB(1, 0), b3, voffB); PG8_STAGE(PG8_SB(1, 1), b3 + hsB, voffB); PG8_STAGE(PG8_SA(1, 0), a3, voffA);
            PG8_WAIT_V(8); PG8_WAIT_L(0); PG8_BAR; PG8_MMA(1, 0, At, B0); PG8_MMA(1, 1, At, B1); PG8_BAR; PG8_SCHED;
        }
        if (wr == 0) PG8_BAR;
        E(acc, cur, wr, wc, fr, fq);
        if (!has_next) break;
#pragma unroll
        for (int a = 0; a < 2; ++a)
#pragma unroll
            for (int b = 0; b < 2; ++b)
#pragma unroll
                for (int m = 0; m < 4; ++m)
#pragma unroll
                    for (int n = 0; n < 2; ++n) acc[a][b][m][n] = (f32x4){0.f, 0.f, 0.f, 0.f};
        cur = nxt; cA = nA; cB = nB; ++ui;
        if (wr == 1) PG8_BAR;
    }
    PG8_WAIT_V(0);
    PG8_BAR;
#undef PG8_RESOLVE
#undef PG8_SA
#undef PG8_SB
#undef PG8_STAGE
#undef PG8_LDA
#undef PG8_LDB
#undef PG8_MMA
#undef PG8_WAIT_V
#undef PG8_WAIT_L
#undef PG8_BAR
#undef PG8_SCHED
}
}

struct Args {
    const float* x; const int* pos; const float* norm1_g; const float* w_in; const float* mla_qg; const float* mla_wuq; const float* mla_kvg; const float* mla_wukv;
    const float* cmp_pe; const float* cmp_w; const float* fox_fb; const float* w_branch; const float* w_out; const float* norm2_g; const float* w_up; const float* w_down; const float* final_g;
    float* out; unsigned char* ws;
};

struct MapId { int off; __device__ int operator()(int n) const { return n + off; } };
struct MapZ { __device__ int operator()(int n) const {
    if (n < 1056) return n; if (n < 1824) return 1068 + (n - 1056); if (n < 2496) return 1840 + (n - 1824);
    if (n < 2508) return 1056 + (n - 2496); if (n < 2512) return 1836 + (n - 2508); if (n < 2520) return n; return -1; } };

template <class Map>
__device__ __forceinline__ void tr_item(const float* src, int sld, const Map map, bf16_t* dst, int dld, int drow0, int dcol0, LAS float* scr, int k0, int n0, int lane, const float* gk = nullptr) {
    const int sc = map(n0 + (lane & 31));
    float tv[32];
#pragma unroll
    for (int i = 0; i < 32; ++i) { const int kk = 2 * i + (lane >> 5); tv[i] = sc >= 0 ? src[(size_t)(k0 + kk) * sld + sc] : 0.f; }
    if (gk) {
#pragma unroll
        for (int i = 0; i < 32; ++i) tv[i] *= gk[k0 + 2 * i + (lane >> 5)]; }
#pragma unroll
    for (int i = 0; i < 32; ++i) { const int kk = 2 * i + (lane >> 5); scr[kk * 33 + (lane & 31)] = tv[i]; }
    LDS_WAIT(); asm volatile("" ::: "memory");
    const int c = lane & 7;
#pragma unroll
    for (int j = 0; j < 4; ++j) { const int n = (lane >> 3) + 8 * j; const LAS float* s = scr + (8 * c) * 33 + n;
        u32x4 o; o.x = pk2(s[0 * 33], s[1 * 33]); o.y = pk2(s[2 * 33], s[3 * 33]); o.z = pk2(s[4 * 33], s[5 * 33]); o.w = pk2(s[6 * 33], s[7 * 33]);
        *(u32x4*)(dst + (size_t)(drow0 + n0 + n) * dld + dcol0 + k0 + 8 * c) = o; }
    LDS_WAIT(); asm volatile("" ::: "memory");
}

template <class AT> __device__ __forceinline__ void p0_weights(const AT& a, int l, LAS unsigned char* lds, int gw, int NGW, int lane, int wave, int part) {
    LAS float* scr = (LAS float*)(lds + wave * 16384);
    unsigned char* ws = a.ws;
    constexpr int I0 = 16 * 80, I1 = 16 * 128, I2 = 4 * 12, I3 = 2 * 16, I5 = 2 * 32 * 2, I6 = 4 * 4 * 32, I7 = 16 * 32, I8 = 16 * 128, I9 = 64 * 32;
    constexpr int NIT = I0 + I1 + I2 + I3 + I5 + I6 + I7 + I8 + I9;
    constexpr int NA = I0 + I1 + I2 + I3 + I5 + I6 + I7;
    const int it_lo = (part == 1) ? NA : 0, it_hi = (part == 0) ? NA : NIT;
    for (int it = it_lo + gw; it < it_hi; it += NGW) {
        int r = it;
        if (r < I0) { tr_item(a.w_in + (size_t)l * DM * INC, INC, MapZ{}, (bf16_t*)(ws + WS_WZ), 1024, 0, 0, scr, (r / 80) * 64, (r % 80) * 32, lane, a.norm1_g + l * DM); continue; } r -= I0;
        if (r < I1) { tr_item(a.w_in + (size_t)l * DM * INC, INC, MapId{2520}, (bf16_t*)(ws + WS_WG), 1024, 0, 0, scr, (r / 128) * 64, (r % 128) * 32, lane, a.norm1_g + l * DM); continue; } r -= I1;
        if (r < I2) { tr_item(a.mla_wuq + (size_t)l * 256 * 384, 384, MapId{0}, (bf16_t*)(ws + WS_WMLA), 384, 0, 0, scr, (r / 12) * 64, (r % 12) * 32, lane); continue; } r -= I2;
        if (r < I3) { tr_item(a.mla_wukv + (size_t)l * 128 * 512, 512, MapId{0}, (bf16_t*)(ws + WS_WMLA), 384, 384, 256, scr, (r / 16) * 64, (r % 16) * 32, lane); continue; } r -= I3;
        if (r < I5) { const int kv = r / 64, q = r % 64; tr_item(a.cmp_w + ((size_t)l * 2 + kv) * 2048 * 64, 64, MapId{0}, (bf16_t*)(ws + WS_WCMP) + (size_t)kv * 256 * 2048, 2048, 0, 0, scr, (q / 2) * 64, (q % 2) * 32, lane); continue; } r -= I5;
        if (r < I6) { const int br = r / 128, q = r % 128; tr_item(a.w_branch + ((size_t)l * 4 + br) * 256 * 1024, 1024, MapId{0}, (bf16_t*)(ws + WS_WBR2) + (size_t)br * 1024 * 1024, 1024, 0, 0, scr, (q / 32) * 64, (q % 32) * 32, lane); continue; } r -= I6;
        if (r < I7) { tr_item(a.w_out + (size_t)l * DM * DM, 1024, MapId{0}, (bf16_t*)(ws + WS_WOUT4), 1024, 0, 0, scr, (r / 32) * 64, (r % 32) * 32, lane); continue; } r -= I7;
        if (r < I8) { tr_item(a.w_up + (size_t)l * DM * DFF, 4096, MapId{0}, (bf16_t*)(ws + WS_WUP), 1024, 0, 0, scr, (r / 128) * 64, (r % 128) * 32, lane, a.norm2_g + l * DM); continue; } r -= I8;
        tr_item(a.w_down + (size_t)l * DFF * DM, 1024, MapId{0}, (bf16_t*)(ws + WS_WDN), 4096, 0, 0, scr, (r / 32) * 64, (r % 32) * 32, lane);
    }
    if (part == 1) return;
    { bf16_t* W = (bf16_t*)(ws + WS_WMLA);
      for (int ch = gw * 64 + lane; ch < 1024 * 48; ch += NGW * 64) { const int row = ch / 48, col = (ch % 48) * 8;
          const bool keep = (row < 384 && col < 256) || (row >= 384 && row < 896 && col >= 256);
          if (!keep) { unsigned zz = 0u; asm volatile("" : "+v"(zz)); *(u32x4*)(W + (size_t)row * 384 + col) = (u32x4){zz, zz, zz, zz}; } } }
    { float* cb = (float*)(ws + WS_CMPB);
      for (int o = gw; o < 128; o += NGW) { const int kv = o >> 6, n = o & 63; const float* pe = a.cmp_pe + ((size_t)l * 2 + kv) * 2048; const float* w = a.cmp_w + ((size_t)l * 2 + kv) * 2048 * 64 + n;
          float s = 0.f; for (int j = lane; j < 2048; j += 64) s += pe[j] * w[(size_t)j * 64];
          s = wave_sum(s); if (lane == 0) cb[o] = s; } }
}

__device__ __forceinline__ void rms_row_bf16(const float* xrow, const float* g, bf16_t* orow, int lane) {
    const f32x4* xr = (const f32x4*)xrow + lane; const f32x4* gr = (const f32x4*)g + lane;
    f32x4 v[4]; float s = 0.f;
#pragma unroll
    for (int j = 0; j < 4; ++j) { v[j] = xr[64 * j]; s += (v[j].x * v[j].x + v[j].y * v[j].y) + (v[j].z * v[j].z + v[j].w * v[j].w); }
    const float rs = 1.0f / sqrtf(wave_sum(s) * (1.f / DM) + NORM_EPS);
    unsigned long long* o8 = (unsigned long long*)orow + lane;
#pragma unroll
    for (int j = 0; j < 4; ++j) { const f32x4 gg = gr[64 * j]; o8[64 * j] = (unsigned long long)pk2(v[j].x * rs * gg.x, v[j].y * rs * gg.y) | ((unsigned long long)pk2(v[j].z * rs * gg.z, v[j].w * rs * gg.w) << 32); }
}
__device__ __forceinline__ void rms_row_f32(float* xrow, const float* g, int lane) {
    f32x4* xr = (f32x4*)xrow + lane; const f32x4* gr = (const f32x4*)g + lane;
    f32x4 v[4]; float s = 0.f;
#pragma unroll
    for (int j = 0; j < 4; ++j) { v[j] = xr[64 * j]; s += (v[j].x * v[j].x + v[j].y * v[j].y) + (v[j].z * v[j].z + v[j].w * v[j].w); }
    const float rs = 1.0f / sqrtf(wave_sum(s) * (1.f / DM) + NORM_EPS);
#pragma unroll
    for (int j = 0; j < 4; ++j) { const f32x4 gg = gr[64 * j]; xr[64 * j] = (f32x4){v[j].x * rs * gg.x, v[j].y * rs * gg.y, v[j].z * rs * gg.z, v[j].w * rs * gg.w}; }
}

__device__ __forceinline__ void sincos_rr(float ang, float& s, float& c) {
    const float k = rintf(ang * 0.15915494309189535f);
    float r = fmaf(-k, 6.28125f, ang); r = fmaf(-k, 1.9353071795864769e-3f, r);
    s = __sinf(r); c = __cosf(r);
}
template <int NT, class AT> __device__ __forceinline__ void prep_tokens(const AT& a, int l, bf16_t* Zp, bf16_t* KCC, bf16_t* VCC, int tok0, int tstride, int lane) {
    bf16_t* z[NT]; float pos[NT];
#pragma unroll
    for (int k = 0; k < NT; ++k) { const int tok = tok0 + k * tstride; z[k] = Zp + (size_t)tok * ZW; pos[k] = (float)a.pos[tok]; }
    {
        u32x2 wq[NT]; unsigned wk[NT];
#pragma unroll
        for (int k = 0; k < NT; ++k) { wq[k] = *(const u32x2*)(z[k] + ZC_CQ + 4 * lane); wk[k] = *(const unsigned*)(z[k] + ZC_CKV + 2 * lane); }
        const f32x4 g = *(const f32x4*)(a.mla_qg + l * 256 + 4 * lane);
        const float g0 = a.mla_kvg[l * 128 + 2 * lane], g1 = a.mla_kvg[l * 128 + 2 * lane + 1];
#pragma unroll
        for (int k = 0; k < NT; ++k) {
            const float v0 = bflo(wq[k].x), v1 = bfhi(wq[k].x), v2 = bflo(wq[k].y), v3 = bfhi(wq[k].y);
            const float rs = 1.0f / sqrtf(wave_sum(v0 * v0 + v1 * v1 + v2 * v2 + v3 * v3) * (1.f / 256.f) + NORM_EPS);
            u32x2 o; o.x = pk2(v0 * rs * g.x, v1 * rs * g.y); o.y = pk2(v2 * rs * g.z, v3 * rs * g.w); *(u32x2*)(z[k] + ZC_CQ + 4 * lane) = o;
            const float u0 = bflo(wk[k]), u1 = bfhi(wk[k]);
            const float rk = 1.0f / sqrtf(wave_sum(u0 * u0 + u1 * u1) * (1.f / 128.f) + NORM_EPS);
            *(unsigned*)(z[k] + ZC_CKV + 2 * lane) = pk2(u0 * rk * g0, u1 * rk * g1);
        }
    }
#pragma unroll
    for (int it = 0; it < 3; ++it) {
        const int p = lane + 64 * it;
        if (p < 148) {
            int col, half, j; float rot;
            if (p < 16) { col = ZC_KR; half = 16; j = p; rot = 32.f; }
            else if (p < 112) { const int v = (p - 16) >> 3; j = (p - 16) & 7; half = 8; rot = 16.f;
                col = v < 4 ? ZC_NQ + 64 * v : v == 4 ? ZC_NKC : v == 5 ? ZC_NKS : v == 6 ? ZC_NKW : v < 11 ? ZC_DQ + 64 * (v - 7) : ZC_DK; }
            else { const int v = (p - 112) >> 2; j = (p - 112) & 3; half = 4; rot = 8.f; col = v < 8 ? ZC_DQI + 32 * v : ZC_DKI; }
            const float inv = exp2f(-((float)(2 * j) / rot) * 18.931568569324174f);
            float x1[NT], x2[NT];
#pragma unroll
            for (int k = 0; k < NT; ++k) { x1[k] = bf2f(z[k][col + j]); x2[k] = bf2f(z[k][col + half + j]); }
#pragma unroll
            for (int k = 0; k < NT; ++k) {
                float sn, cs; sincos_rr(pos[k] * inv, sn, cs);
                const unsigned y1 = f2bf(x1[k] * cs - x2[k] * sn), y2 = f2bf(x2[k] * cs + x1[k] * sn);
                z[k][col + j] = (bf16_t)y1; z[k][col + half + j] = (bf16_t)y2;
                if (col == ZC_NKC) { const size_t tb = (size_t)(tok0 + k * tstride) * 64; KCC[tb + j] = (bf16_t)y1; KCC[tb + 8 + j] = (bf16_t)y2; }
            }
        }
    }
    unsigned cp[NT];
#pragma unroll
    for (int k = 0; k < NT; ++k) cp[k] = (lane < 24) ? *(const unsigned*)(z[k] + ZC_NKC + 16 + 2 * lane) : (lane >= 32 ? *(const unsigned*)(z[k] + ZC_NVC + 2 * (lane - 32)) : 0u);
#pragma unroll
    for (int k = 0; k < NT; ++k) { const size_t tb = (size_t)(tok0 + k * tstride) * 64;
        if (lane < 24) *(unsigned*)(KCC + tb + 16 + 2 * lane) = cp[k];
        if (lane >= 32) *(unsigned*)(VCC + tb + 2 * (lane - 32)) = cp[k]; }
}
template <class AT> __device__ __forceinline__ void fox_scan(const AT& a, int l, const bf16_t* Z, float* FC, int bh, int lane) {
    const int b = bh >> 2, h = bh & 3; const float fb = a.fox_fb[l * 4 + h];
    float v[32]; float tot = 0.f;
#pragma unroll
    for (int i = 0; i < 32; ++i) { const int t = lane * 32 + i; const float x = bf2f(Z[(size_t)(b * SEQ + t) * ZW + ZC_FF + h]) + fb;
        const float ls = fminf(x, 0.f) - logf(1.f + expf(-fabsf(x))); tot += ls; v[i] = tot; }
    float incl = tot;
#pragma unroll
    for (int o = 1; o < 64; o <<= 1) { const float n = __shfl_up(incl, o); if (lane >= o) incl += n; }
    const float excl = incl - tot;
#pragma unroll
    for (int i = 0; i < 32; ++i) FC[(size_t)(b * SEQ + lane * 32 + i) * 4 + h] = excl + v[i];
}

namespace att {
constexpr int VROW = 144;
constexpr int OFF_K = 0, OFF_V = 2 * 64 * 208, OFF_KB = OFF_V + 2 * 64 * VROW, OFF_MISC = OFF_KB + 2 * 64 * 4;
__device__ __forceinline__ int kslot(int k) { return (k & 32) + (k & 3) + 4 * ((k >> 4) & 1) + 8 * ((k >> 2) & 3); }

template <int DK, class P> struct Stage {
    static constexpr int KROW = DK * 2 + 16, CPR = DK / 8, NCH = (64 * CPR + 511) / 512;
    u32x4 kreg[NCH]; u32x4 v0, v1; float kb;
    __device__ __forceinline__ void load(const P& pol, int kt, int tid) {
#pragma unroll
        for (int i = 0; i < NCH; ++i) { const int id = tid + i * 512; if (id < 64 * CPR) { const int key = id / CPR, ch = id % CPR; kreg[i] = *(const u32x4*)pol.kptr(kt * 64 + key, ch); } }
        if (tid < 256) { const int p = tid & 31, dch = tid >> 5; v0 = *(const u32x4*)pol.vptr(kt * 64 + 2 * p, dch); v1 = *(const u32x4*)pol.vptr(kt * 64 + 2 * p + 1, dch); }
        if constexpr (P::HAS_KBIAS) { if (tid >= 256 && tid < 320) kb = pol.kbias(kt * 64 + tid - 256); }
    }
    __device__ __forceinline__ void store(LAS unsigned char* lds, int buf, int tid) {
#pragma unroll
        for (int i = 0; i < NCH; ++i) { const int id = tid + i * 512; if (id < 64 * CPR) { const int key = id / CPR, ch = id % CPR;
            *(LAS u32x4*)(lds + OFF_K + buf * 64 * KROW + kslot(key) * KROW + ch * 16) = kreg[i]; } }
        if (tid < 256) { const int p = tid & 31, dch = tid >> 5; LAS unsigned char* vb = lds + OFF_V + buf * 64 * VROW + (8 * dch) * VROW + p * 4;
#pragma unroll
            for (int j = 0; j < 4; ++j) { *(LAS unsigned*)(vb + (2 * j) * VROW) = (v0[j] & 0xffffu) | (v1[j] << 16); *(LAS unsigned*)(vb + (2 * j + 1) * VROW) = (v0[j] >> 16) | (v1[j] & 0xffff0000u); } }
        if (P::HAS_KBIAS) { if (tid >= 256 && tid < 320) *(LAS float*)(lds + OFF_KB + buf * 256 + (tid - 256) * 4) = kb; }
    }
};


template <int DK> __device__ __forceinline__ void qk_scores(LAS unsigned char* lds, int buf, const bf16x8 (&qf)[DK / 16], int r32, int hi, f32x16& s0, f32x16& s1) {
    constexpr int KROW = DK * 2 + 16;
#pragma unroll
    for (int r = 0; r < 16; ++r) { s0[r] = 0.f; s1[r] = 0.f; }
    const LAS unsigned char* kb0 = lds + OFF_K + buf * 64 * KROW + r32 * KROW + hi * 16;
#pragma unroll
    for (int stp = 0; stp < DK / 16; ++stp) {
        const bf16x8 k0 = *(const LAS bf16x8*)(kb0 + stp * 32), k1 = *(const LAS bf16x8*)(kb0 + 32 * KROW + stp * 32);
        s0 = __builtin_amdgcn_mfma_f32_32x32x16_bf16(k0, qf[stp], s0, 0, 0, 0);
        s1 = __builtin_amdgcn_mfma_f32_32x32x16_bf16(k1, qf[stp], s1, 0, 0, 0);
    }
}
__device__ __forceinline__ void pv_acc(LAS unsigned char* lds, int buf, int r32, int hi, const f32x16& s0, const f32x16& s1, f32x16 (&o)[2]) {
    const LAS unsigned char* vb0 = lds + OFF_V + buf * 64 * VROW + r32 * VROW + hi * 32;
#pragma unroll
    for (int half = 0; half < 2; ++half)
#pragma unroll
        for (int j = 0; j < 2; ++j) {
            const f32x16& s = half ? s1 : s0;
            u32x4 pw; pw.x = cvt_pk_bf16(s[8 * j + 0], s[8 * j + 1]); pw.y = cvt_pk_bf16(s[8 * j + 2], s[8 * j + 3]); pw.z = cvt_pk_bf16(s[8 * j + 4], s[8 * j + 5]); pw.w = cvt_pk_bf16(s[8 * j + 6], s[8 * j + 7]);
            const bf16x8 pb = __builtin_bit_cast(bf16x8, pw);
            const bf16x8 va = *(const LAS bf16x8*)(vb0 + half * 64 + j * 16), vc = *(const LAS bf16x8*)(vb0 + 32 * VROW + half * 64 + j * 16);
            o[0] = __builtin_amdgcn_mfma_f32_32x32x16_bf16(va, pb, o[0], 0, 0, 0);
            o[1] = __builtin_amdgcn_mfma_f32_32x32x16_bf16(vc, pb, o[1], 0, 0, 0);
        }
}
template <int DK, class P>
__device__ __forceinline__ void flash_run(LAS unsigned char* lds, P& pol, unsigned tmask, const bf16x8 (&qf)[DK / 16], float& m_run, float& l_run, f32x16 (&o)[2], int tid) {
    const int lane = tid & 63, r32 = lane & 31, hi = lane >> 5;
    if (tmask == 0u) return;
    Stage<DK, P> st;
    int kt = __builtin_ctz(tmask); tmask &= tmask - 1;
    st.load(pol, kt, tid);
    __syncthreads();
    st.store(lds, 0, tid);
    __syncthreads();
    int buf = 0;
    for (;;) {
        const int ktn = tmask ? __builtin_ctz(tmask) : -1; if (tmask) tmask &= tmask - 1;
        if (ktn >= 0) st.load(pol, ktn, tid);
        if (!pol.wave_skip(kt)) {
            pol.prep(kt);
            f32x16 s0, s1;
            qk_scores<DK>(lds, buf, qf, r32, hi, s0, s1);
            float mx = NEGF;
            const bool full = pol.full(kt);
            if constexpr (P::HAS_KBIAS) {
                const LAS float* kbl = (const LAS float*)(lds + OFF_KB + buf * 256) + 16 * hi;
#pragma unroll
                for (int r = 0; r < 16; ++r) { s0[r] = fmaf(s0[r], pol.c2, pol.qbias - kbl[r]); s1[r] = fmaf(s1[r], pol.c2, pol.qbias - kbl[32 + r]); }
            }
            if (!full) {
#pragma unroll
                for (int r = 0; r < 16; ++r) { s0[r] = pol.valid(kt, 0, r) ? s0[r] : NEGF; s1[r] = pol.valid(kt, 1, r) ? s1[r] : NEGF; }
            }
            { float ma = s0[0], mb = s1[0], mc = s0[1], md = s1[1];
#pragma unroll
              for (int r = 2; r < 16; r += 2) { ma = fmax1(ma, s0[r]); mb = fmax1(mb, s1[r]); mc = fmax1(mc, s0[r + 1]); md = fmax1(md, s1[r + 1]); }
              mx = fmax1(fmax1(ma, mb), fmax1(mc, md)); }
            mx = fmax1(mx, xchg32(mx));
            float ls = 0.f; float m_new;
            if constexpr (P::HAS_KBIAS) {
                m_new = fmaxf(m_run, mx);
#pragma unroll
                for (int r = 0; r < 16; ++r) { s0[r] = __builtin_amdgcn_exp2f(s0[r] - m_new); s1[r] = __builtin_amdgcn_exp2f(s1[r] - m_new); ls += s0[r] + s1[r]; }
            } else {
                m_new = fmaxf(m_run, mx * pol.c2);
#pragma unroll
                for (int r = 0; r < 16; ++r) { s0[r] = __builtin_amdgcn_exp2f(fmaf(s0[r], pol.c2, -m_new)); s1[r] = __builtin_amdgcn_exp2f(fmaf(s1[r], pol.c2, -m_new)); ls += s0[r] + s1[r]; }
            }
            const float alpha = __builtin_amdgcn_exp2f(m_run - m_new);
            l_run = l_run * alpha + ls; m_run = m_new;
            if (__ballot(alpha != 1.f) != 0ull) {
#pragma unroll
                for (int r = 0; r < 16; ++r) { o[0][r] *= alpha; o[1][r] *= alpha; }
            }
            pv_acc(lds, buf, r32, hi, s0, s1, o);
        }
        if (ktn < 0) break;
        st.store(lds, buf ^ 1, tid);
        __syncthreads();
        buf ^= 1; kt = ktn;
    }
}
__device__ __forceinline__ void store_o(bf16_t* orow, const f32x16 (&o)[2], float w, int hi) {
#pragma unroll
    for (int dacc = 0; dacc < 2; ++dacc)
#pragma unroll
        for (int g = 0; g < 4; ++g) { u32x2 v; v.x = cvt_pk_bf16(o[dacc][4 * g] * w, o[dacc][4 * g + 1] * w); v.y = cvt_pk_bf16(o[dacc][4 * g + 2] * w, o[dacc][4 * g + 3] * w);
            *(u32x2*)(orow + dacc * 32 + 8 * g + 4 * hi) = v; }
}

struct PolFox {
    static constexpr bool HAS_KBIAS = true;
    const bf16_t* zb; const float* fc; int h; int t; int hi; int wlast; float c2, qbias;
    __device__ __forceinline__ const bf16_t* kptr(int key, int ch) const { return zb + (size_t)key * ZW + ZC_FK + h * 64 + ch * 8; }
    __device__ __forceinline__ const bf16_t* vptr(int key, int dch) const { return zb + (size_t)key * ZW + ZC_FV + h * 64 + dch * 8; }
    __device__ __forceinline__ float kbias(int key) const { return fc[(size_t)key * 4 + h] * LOG2E; }
    __device__ __forceinline__ bool wave_skip(int kt) const { return kt * 64 > wlast; }
    __device__ __forceinline__ bool full(int kt) const { return kt * 64 + 63 <= wlast - 31; }
    __device__ __forceinline__ void prep(int) {}
    __device__ __forceinline__ bool valid(int kt, int half, int r) const { return kt * 64 + 32 * half + 16 * hi + r <= t; }
};
__device__ __forceinline__ void fox_unit(LAS unsigned char* lds, const bf16_t* Z, const float* FC, bf16_t* O, int b, int h, int qb, int tid) {
    const int lane = tid & 63, r32 = lane & 31, hi = lane >> 5, wave = tid >> 6;
    const int t = qb * 256 + wave * 32 + r32;
    PolFox pol; pol.zb = Z + (size_t)b * SEQ * ZW; pol.fc = FC + (size_t)b * SEQ * 4; pol.h = h; pol.t = t; pol.hi = hi; pol.wlast = qb * 256 + wave * 32 + 31; pol.c2 = 0.125f * LOG2E;
    pol.qbias = pol.fc[(size_t)t * 4 + h] * LOG2E;
    bf16x8 qf[4];
    const bf16_t* qrow = pol.zb + (size_t)t * ZW + ZC_FQ + h * 64;
#pragma unroll
    for (int s = 0; s < 4; ++s) qf[s] = *(const bf16x8*)(qrow + s * 16 + 8 * hi);
    float m_run = -1e20f, l_run = 0.f; f32x16 o[2];
#pragma unroll
    for (int r = 0; r < 16; ++r) { o[0][r] = 0.f; o[1][r] = 0.f; }
    const unsigned tmask = (qb == 7) ? 0xffffffffu : ((1u << (4 * qb + 4)) - 1u);
    flash_run<64, PolFox>(lds, pol, tmask, qf, m_run, l_run, o, tid);
    const float lt = l_run + xchg32(l_run);
    store_o(O + (size_t)(b * SEQ + t) * DM + 512 + h * 64, o, lt > 0.f ? 1.f / lt : 0.f, hi);
}

struct PolMla {
    static constexpr bool HAS_KBIAS = false;
    const bf16_t* qb_; const bf16_t* zb; int h; int t; int hi; int wlast; float c2;
    __device__ __forceinline__ const bf16_t* kptr(int key, int ch) const { return ch < 8 ? qb_ + (size_t)key * 1024 + 384 + h * 128 + ch * 8 : zb + (size_t)key * ZW + ZC_KR + (ch - 8) * 8; }
    __device__ __forceinline__ const bf16_t* vptr(int key, int dch) const { return qb_ + (size_t)key * 1024 + 384 + h * 128 + 64 + dch * 8; }
    __device__ __forceinline__ bool wave_skip(int kt) const { return kt * 64 > wlast; }
    __device__ __forceinline__ bool full(int kt) const { return kt * 64 + 63 <= wlast - 31; }
    __device__ __forceinline__ void prep(int) {}
    __device__ __forceinline__ bool valid(int kt, int half, int r) const { return kt * 64 + 32 * half + 16 * hi + r <= t; }
};
__device__ __forceinline__ void mla_unit(LAS unsigned char* lds, const bf16_t* QKVM, const bf16_t* Z, const int* posp, bf16_t* O, int b, int h, int qb, int tid) {
    const int lane = tid & 63, r32 = lane & 31, hi = lane >> 5, wave = tid >> 6;
    const int t = qb * 256 + wave * 32 + r32;
    PolMla pol; pol.qb_ = QKVM + (size_t)b * SEQ * 1024; pol.zb = Z + (size_t)b * SEQ * ZW; pol.h = h; pol.t = t; pol.hi = hi; pol.wlast = qb * 256 + wave * 32 + 31;
    pol.c2 = 0.10206207261596577f * LOG2E;
    bf16x8 qf[6];
    const bf16_t* qrow = pol.qb_ + (size_t)t * 1024 + h * 96;
#pragma unroll
    for (int s = 0; s < 6; ++s) qf[s] = *(const bf16x8*)(qrow + s * 16 + 8 * hi);
    {
        const float pos = (float)posp[b * SEQ + t];
        u32x4 a4 = __builtin_bit_cast(u32x4, qf[4]), b4 = __builtin_bit_cast(u32x4, qf[5]);
        float x1[8], x2[8];
#pragma unroll
        for (int i = 0; i < 4; ++i) { x1[2 * i] = bflo(a4[i]); x1[2 * i + 1] = bfhi(a4[i]); x2[2 * i] = bflo(b4[i]); x2[2 * i + 1] = bfhi(b4[i]); }
#pragma unroll
        for (int i = 0; i < 8; ++i) { const int j = 8 * hi + i; const float inv = __builtin_amdgcn_exp2f(-((float)(2 * j) / 32.f) * 18.931568569324174f);
            float sn, cs; sincos_rr(pos * inv, sn, cs); const float y1 = x1[i] * cs - x2[i] * sn, y2 = x2[i] * cs + x1[i] * sn; x1[i] = y1; x2[i] = y2; }
#pragma unroll
        for (int i = 0; i < 4; ++i) { a4[i] = cvt_pk_bf16(x1[2 * i], x1[2 * i + 1]); b4[i] = cvt_pk_bf16(x2[2 * i], x2[2 * i + 1]); }
        qf[4] = __builtin_bit_cast(bf16x8, a4); qf[5] = __builtin_bit_cast(bf16x8, b4);
    }
    float m_run = -1e20f, l_run = 0.f; f32x16 o[2];
#pragma unroll
    for (int r = 0; r < 16; ++r) { o[0][r] = 0.f; o[1][r] = 0.f; }
    const unsigned tmask = (qb == 7) ? 0xffffffffu : ((1u << (4 * qb + 4)) - 1u);
    flash_run<96, PolMla>(lds, pol, tmask, qf, m_run, l_run, o, tid);
    const float lt = l_run + xchg32(l_run);
    store_o(O + (size_t)(b * SEQ + t) * DM + 0 + h * 64, o, lt > 0.f ? 1.f / lt : 0.f, hi);
}

struct PolDsa {
    static constexpr bool HAS_KBIAS = false;
    const bf16_t* zb; const unsigned long long* selrow; int hi; int wlast; float c2; unsigned m0, m1;
    __device__ __forceinline__ const bf16_t* kptr(int key, int ch) const { return zb + (size_t)key * ZW + ZC_DK + ch * 8; }
    __device__ __forceinline__ const bf16_t* vptr(int key, int dch) const { return zb + (size_t)key * ZW + ZC_DV + dch * 8; }
    __device__ __forceinline__ bool wave_skip(int kt) const { return kt * 64 > wlast; }
    __device__ __forceinline__ bool full(int) const { return false; }
    __device__ __forceinline__ void prep(int kt) { const unsigned long long w = selrow[kt]; m0 = (unsigned)(w >> (16 * hi)); m1 = (unsigned)(w >> (32 + 16 * hi)); }
    __device__ __forceinline__ bool valid(int kt, int half, int r) const { return (((half ? m1 : m0) >> r) & 1u) != 0u; }
};
__device__ __forceinline__ void dsa_unit(LAS unsigned char* lds, const bf16_t* Z, const unsigned long long* SELM, bf16_t* O, int b, int tq, int tid) {
    const int lane = tid & 63, r32 = lane & 31, hi = lane >> 5, wave = tid >> 6, h = wave >> 1;
    const int t = tq * 64 + (wave & 1) * 32 + r32;
    PolDsa pol; pol.zb = Z + (size_t)b * SEQ * ZW; pol.selrow = SELM + (size_t)(b * SEQ + t) * 32; pol.hi = hi; pol.wlast = tq * 64 + (wave & 1) * 32 + 31; pol.c2 = 0.125f * LOG2E; pol.m0 = 0; pol.m1 = 0;
    bf16x8 qf[4];
    const bf16_t* qrow = pol.zb + (size_t)t * ZW + ZC_DQ + h * 64;
#pragma unroll
    for (int s = 0; s < 4; ++s) qf[s] = *(const bf16x8*)(qrow + s * 16 + 8 * hi);
    float m_run = -1e20f, l_run = 0.f; f32x16 o[2];
#pragma unroll
    for (int r = 0; r < 16; ++r) { o[0][r] = 0.f; o[1][r] = 0.f; }
    const unsigned tmask = (tq == 31) ? 0xffffffffu : ((1u << (tq + 1)) - 1u);
    flash_run<64, PolDsa>(lds, pol, tmask, qf, m_run, l_run, o, tid);
    const float lt = l_run + xchg32(l_run);
    store_o(O + (size_t)(b * SEQ + t) * DM + 768 + h * 64, o, lt > 0.f ? 1.f / lt : 0.f, hi);
}

__device__ __forceinline__ void dsa_index_unit(LAS unsigned char* lds, const bf16_t* Z, unsigned long long* SELM, int b, int tq16, int tid) {
    const int lane = tid & 63, r32 = lane & 31, hi = lane >> 5, wave = __builtin_amdgcn_readfirstlane(tid >> 6);
    const int t0 = tq16 * 16, ntile = (t0 + 16 + 31) >> 5;
    const bf16_t* zb = Z + (size_t)b * SEQ * ZW;
    LAS float* sc = (LAS float*)lds;
    __syncthreads();
    {
        const int mt = wave & 3, kpar = wave >> 2;
        const int ql_a = r32 >> 3, hh_a = r32 & 7;
        const bf16_t* qirow = zb + (size_t)(t0 + 4 * mt + ql_a) * ZW + ZC_DQI + hh_a * 32 + 8 * hi;
        const bf16x8 a0 = *(const bf16x8*)(qirow), a1 = *(const bf16x8*)(qirow + 16);
        float wv[4][4];
#pragma unroll
        for (int ql = 0; ql < 4; ++ql) { const u32x2 w = *(const u32x2*)(zb + (size_t)(t0 + 4 * mt + ql) * ZW + ZC_DW + 4 * hi);
            wv[ql][0] = bflo(w.x) * 0.0625f; wv[ql][1] = bfhi(w.x) * 0.0625f; wv[ql][2] = bflo(w.y) * 0.0625f; wv[ql][3] = bfhi(w.y) * 0.0625f; }
        bf16x8 xa0[4], xa1[4], xb0[4], xb1[4];
        auto ldb = [&](int tile0, bf16x8 (&b0)[4], bf16x8 (&b1)[4]) {
#pragma unroll
            for (int i2 = 0; i2 < 4; ++i2) { const int tile = tile0 + 2 * i2; const int key = (tile < ntile ? tile : kpar) * 32 + r32;
                const bf16_t* kirow = zb + (size_t)key * ZW + ZC_DKI + 8 * hi; b0[i2] = *(const bf16x8*)(kirow); b1[i2] = *(const bf16x8*)(kirow + 16); }
        };
        auto score = [&](int tile0, const bf16x8 (&b0)[4], const bf16x8 (&b1)[4]) {
#pragma unroll
            for (int i2 = 0; i2 < 4; ++i2) { const int tile = tile0 + 2 * i2; if (tile < ntile) {
                const int key = tile * 32 + r32;
                f32x16 sv;
#pragma unroll
                for (int r = 0; r < 16; ++r) sv[r] = 0.f;
                sv = __builtin_amdgcn_mfma_f32_32x32x16_bf16(a0, b0[i2], sv, 0, 0, 0);
                sv = __builtin_amdgcn_mfma_f32_32x32x16_bf16(a1, b1[i2], sv, 0, 0, 0);
                float p0 = 0.f, p1 = 0.f, p2 = 0.f, p3 = 0.f;
#pragma unroll
                for (int e = 0; e < 4; ++e) { p0 += fmax1(sv[e], 0.f) * wv[0][e]; p1 += fmax1(sv[4 + e], 0.f) * wv[1][e]; p2 += fmax1(sv[8 + e], 0.f) * wv[2][e]; p3 += fmax1(sv[12 + e], 0.f) * wv[3][e]; }
                p0 += xchg32(p0); p1 += xchg32(p1); p2 += xchg32(p2); p3 += xchg32(p3);
                const float va = hi ? p2 : p0, vb = hi ? p3 : p1;
                const int qa = 4 * mt + 2 * hi;
                sc[qa * 2048 + key] = (key <= t0 + qa) ? va : NEGF;
                sc[(qa + 1) * 2048 + key] = (key <= t0 + qa + 1) ? vb : NEGF; } }
        };
        int tile0 = kpar;
        if (tile0 < ntile) ldb(tile0, xa0, xa1);
        while (tile0 < ntile) {
            if (tile0 + 8 < ntile) ldb(tile0 + 8, xb0, xb1);
            score(tile0, xa0, xa1);
            tile0 += 8; if (tile0 >= ntile) break;
            if (tile0 + 8 < ntile) ldb(tile0 + 8, xa0, xa1);
            score(tile0, xb0, xb1);
            tile0 += 8;
        }
    }
    __syncthreads();
#pragma unroll 1
    for (int rr = 0; rr < 2; ++rr) {
        const int q = wave * 2 + rr, t = t0 + q;
        unsigned long long mine = 0ull;
        if (t + 1 <= 256) {
#pragma unroll
            for (int j = 0; j < 32; ++j) { const unsigned long long bal = __ballot(j * 64 + lane <= t); if (lane == j) mine = bal; }
        } else {
            unsigned u[32];
#pragma unroll
            for (int j = 0; j < 32; ++j) { const int key = j * 64 + lane; unsigned bits = 0u;
                if (key <= t) { const unsigned fb = __float_as_uint(sc[q * 2048 + key]); bits = (fb & 0x80000000u) ? ~fb : (fb | 0x80000000u); }
                u[j] = bits; }
            int cpos = 0;
#pragma unroll
            for (int j = 0; j < 32; ++j) cpos += (u[j] >= 0x80000000u) ? 1 : 0;
            cpos = (int)wred_add((unsigned)cpos);
            const bool pcls = cpos >= 256;
            unsigned umax = 0u, umin = 0xffffffffu;
#pragma unroll
            for (int j = 0; j < 32; ++j) { const bool in = pcls ? (u[j] >= 0x80000000u) : (u[j] < 0x80000000u && u[j] != 0u);
                const unsigned vmx = in ? u[j] : 0u, vmn = in ? u[j] : 0xffffffffu; umax = vmx > umax ? vmx : umax; umin = vmn < umin ? vmn : umin; }
            umax = wred_umax(umax); umin = ~wred_umax(~umin);
            const unsigned xr = umax ^ umin;
            int bw = xr ? 32 - __builtin_clz(xr) : 0;
            unsigned T = (umax >> bw) << bw;
            int cntT = pcls ? cpos : t + 1, cntHi = pcls ? 0 : cpos;
            bool compact = false; unsigned uc = 0u; int aboveC = 0;
            LAS unsigned* cbuf = (LAS unsigned*)(lds + 131072 + 1024) + wave * 64;
#pragma unroll 1
            while (bw > 0) {
                if (!compact && bw < 32 && cntT - cntHi <= 64) {
                    int base = 0; const unsigned long long ltm = (lane == 0) ? 0ull : (~0ull >> (64 - lane));
#pragma unroll
                    for (int j = 0; j < 32; ++j) { const bool act = (u[j] - T) < (1u << bw) && u[j] >= T && u[j] != 0u; const unsigned long long bal = __ballot(act);
                        if (act) cbuf[base + __builtin_popcountll(bal & ltm)] = u[j]; base += __builtin_popcountll(bal); }
                    LDS_WAIT();
                    uc = (lane < base) ? cbuf[lane] : 0u;
                    LDS_WAIT();
                    compact = true; aboveC = cntHi;
                }
                --bw;
                const unsigned cand = T + (1u << bw); int c;
                if (compact) c = aboveC + __builtin_popcountll(__ballot(uc >= cand));
                else { c = 0;
#pragma unroll
                    for (int j = 0; j < 32; ++j) c += (u[j] >= cand) ? 1 : 0;
                    c = (int)wred_add((unsigned)c); }
                if (c >= 256) { T = cand; cntT = c; } else cntHi = c;
            }
            if (cntT == 256) {
#pragma unroll
                for (int j = 0; j < 32; ++j) { const unsigned long long bal = __ballot(u[j] >= T); if (lane == j) mine = bal; }
            } else {
                int need = 256 - cntHi;
                const unsigned long long lt_mask = (lane == 0) ? 0ull : (~0ull >> (64 - lane));
#pragma unroll
                for (int j = 0; j < 32; ++j) { const unsigned long long gt = __ballot(u[j] > T), eq = __ballot(u[j] == T);
                    const int rank = __builtin_popcountll(eq & lt_mask);
                    const unsigned long long take = __ballot(u[j] == T && rank < need);
                    need -= __builtin_popcountll(take); if (need < 0) need = 0;
                    const unsigned long long bal = gt | take; if (lane == j) mine = bal; }
            }
        }
        if (lane < 32) SELM[(size_t)(b * SEQ + t) * 32 + lane] = mine;
    }
}

constexpr int OFF_IMPA = OFF_MISC, IMP_BYTES = 4 * 64 * 33 * 4, OFF_IMPB = OFF_IMPA + IMP_BYTES, OFF_SELQ = OFF_IMPB + IMP_BYTES, OFF_SELU = OFF_SELQ + 256;
struct PolCmp {
    static constexpr bool HAS_KBIAS = false;
    const bf16_t* kc; const bf16_t* vc;
    __device__ __forceinline__ const bf16_t* kptr(int key, int ch) const { return kc + (size_t)key * 64 + ch * 8; }
    __device__ __forceinline__ const bf16_t* vptr(int key, int dch) const { return vc + (size_t)key * 64 + dch * 8; }
};
struct PolSel {
    static constexpr bool HAS_KBIAS = false;
    const bf16_t* zb; int t; int hi; unsigned selq; float c2;
    __device__ __forceinline__ const bf16_t* kptr(int key, int ch) const { return zb + (size_t)key * ZW + ZC_NKS + ch * 8; }
    __device__ __forceinline__ const bf16_t* vptr(int key, int dch) const { return zb + (size_t)key * ZW + ZC_NVS + dch * 8; }
    __device__ __forceinline__ bool wave_skip(int kt) const { return __ballot((selq >> kt) & 1u) == 0ull; }
    __device__ __forceinline__ bool full(int) const { return false; }
    __device__ __forceinline__ void prep(int) {}
    __device__ __forceinline__ bool valid(int kt, int half, int r) const { return ((selq >> kt) & 1u) && (kt * 64 + 32 * half + 16 * hi + r <= t); }
};
struct PolWin {
    static constexpr bool HAS_KBIAS = false;
    const bf16_t* zb; int t; int hi; int w0; float c2;
    __device__ __forceinline__ const bf16_t* kptr(int key, int ch) const { return zb + (size_t)key * ZW + ZC_NKW + ch * 8; }
    __device__ __forceinline__ const bf16_t* vptr(int key, int dch) const { return zb + (size_t)key * ZW + ZC_NVW + dch * 8; }
    __device__ __forceinline__ bool wave_skip(int kt) const { return (kt * 64 > w0 + 31) || (kt * 64 + 63 <= w0 - 512); }
    __device__ __forceinline__ bool full(int kt) const { return (kt * 64 + 63 <= w0) && (kt * 64 > w0 + 31 - 512); }
    __device__ __forceinline__ void prep(int) {}
    __device__ __forceinline__ bool valid(int kt, int half, int r) const { const int key = kt * 64 + 32 * half + 16 * hi + r; return key <= t && key > t - 512; }
};
__device__ __forceinline__ void nsa_unit(LAS unsigned char* lds, const bf16_t* Z, const bf16_t* KCMP, const bf16_t* VCMP, bf16_t* O, int b, int tq, int tid) {
    const int lane = tid & 63, r32 = lane & 31, hi = lane >> 5, wave = tid >> 6, h = wave >> 1;
    const int ql = (wave & 1) * 32 + r32, t = tq * 64 + ql;
    const bf16_t* zb = Z + (size_t)b * SEQ * ZW;
    const float c2 = 0.125f * LOG2E;
    bf16x8 qf[4];
    const bf16_t* qrow = zb + (size_t)t * ZW + ZC_NQ + h * 64;
#pragma unroll
    for (int s = 0; s < 4; ++s) qf[s] = *(const bf16x8*)(qrow + s * 16 + 8 * hi);
    float g0, g1, g2;
    { const bf16_t* gp = zb + (size_t)t * ZW + ZC_NG; g0 = 1.f / (1.f + __expf(-bf2f(gp[h]))); g1 = 1.f / (1.f + __expf(-bf2f(gp[4 + h]))); g2 = 1.f / (1.f + __expf(-bf2f(gp[8 + h]))); }
    f32x16 ot[2];
#pragma unroll
    for (int r = 0; r < 16; ++r) { ot[0][r] = 0.f; ot[1][r] = 0.f; }
    LAS float* impA = (LAS float*)(lds + OFF_IMPA); LAS float* impB = (LAS float*)(lds + OFF_IMPB);
    LAS unsigned* selq_l = (LAS unsigned*)(lds + OFF_SELQ); LAS unsigned* selu_l = (LAS unsigned*)(lds + OFF_SELU);
    {
        PolCmp pc; pc.kc = KCMP + (size_t)b * 128 * 64; pc.vc = VCMP + (size_t)b * 128 * 64;
        {
            Stage<64, PolCmp> st;
            __syncthreads();
            st.load(pc, 0, tid); st.store(lds, 0, tid);
            st.load(pc, 1, tid); st.store(lds, 1, tid);
            if (tid < 64) { selu_l[0] = 0u; selq_l[tid] = 0u; }
            __syncthreads();
        }
        float mx = NEGF;
#pragma unroll 1
        for (int kt = 0; kt < 2; ++kt) {
            f32x16 s0, s1;
            qk_scores<64>(lds, kt, qf, r32, hi, s0, s1);
#pragma unroll
            for (int r = 0; r < 16; ++r) { const int c0 = 64 * kt + 16 * hi + r, c1 = c0 + 32;
                if ((c0 * 16 + 31 <= t) && (c0 < 127)) mx = fmaxf(mx, s0[r] * c2);
                if ((c1 * 16 + 31 <= t) && (c1 < 127)) mx = fmaxf(mx, s1[r] * c2); }
        }
        mx = fmaxf(mx, xchg32(mx));
        float ls = 0.f;
        f32x16 oc[2];
#pragma unroll
        for (int r = 0; r < 16; ++r) { oc[0][r] = 0.f; oc[1][r] = 0.f; }
#pragma unroll 1
        for (int kt = 0; kt < 2; ++kt) {
            f32x16 s0, s1;
            qk_scores<64>(lds, kt, qf, r32, hi, s0, s1);
#pragma unroll
            for (int r = 0; r < 16; ++r) { const int c0 = 64 * kt + 16 * hi + r, c1 = c0 + 32;
                s0[r] = ((c0 * 16 + 31 <= t) && (c0 < 127)) ? __builtin_amdgcn_exp2f(s0[r] * c2 - mx) : 0.f;
                s1[r] = ((c1 * 16 + 31 <= t) && (c1 < 127)) ? __builtin_amdgcn_exp2f(s1[r] * c2 - mx) : 0.f;
                ls += s0[r] + s1[r]; }
#pragma unroll
            for (int a = 0; a < 4; ++a) {
                { const int j1 = 16 * kt + 4 * hi + a; const float p3 = 0.5f * s0[4 * a + 3];
                  impA[(h * 64 + ql) * 33 + j1] = s0[4 * a] + s0[4 * a + 1] + s0[4 * a + 2] + p3; impB[(h * 64 + ql) * 33 + j1 + 1] = p3; }
                { const int j1 = 16 * kt + 8 + 4 * hi + a; const float p3 = 0.5f * s1[4 * a + 3];
                  impA[(h * 64 + ql) * 33 + j1] = s1[4 * a] + s1[4 * a + 1] + s1[4 * a + 2] + p3; if (j1 + 1 < 32) impB[(h * 64 + ql) * 33 + j1 + 1] = p3; }
            }
            pv_acc(lds, kt, r32, hi, s0, s1, oc);
        }
        ls += xchg32(ls);
        const float inv = ls > 0.f ? 1.f / ls : 0.f;
        if (hi == 0) impA[(h * 64 + ql) * 33 + 32] = inv;
#pragma unroll
        for (int r = 0; r < 16; ++r) { ot[0][r] = g0 * inv * oc[0][r]; ot[1][r] = g0 * inv * oc[1][r]; }
    }
    __syncthreads();
    {
        const int q = tid & 63, part = tid >> 6;
        LAS float* row = impA + q * 33;
        const float iv0 = impA[(0 * 64 + q) * 33 + 32], iv1 = impA[(1 * 64 + q) * 33 + 32], iv2 = impA[(2 * 64 + q) * 33 + 32], iv3 = impA[(3 * 64 + q) * 33 + 32];
        float xv[4];
#pragma unroll
        for (int jj = 0; jj < 4; ++jj) { const int j = 4 * part + jj;
            float x = iv0 * (impA[(0 * 64 + q) * 33 + j] + (j > 0 ? impB[(0 * 64 + q) * 33 + j] : 0.f));
            x += iv1 * (impA[(1 * 64 + q) * 33 + j] + (j > 0 ? impB[(1 * 64 + q) * 33 + j] : 0.f));
            x += iv2 * (impA[(2 * 64 + q) * 33 + j] + (j > 0 ? impB[(2 * 64 + q) * 33 + j] : 0.f));
            x += iv3 * (impA[(3 * 64 + q) * 33 + j] + (j > 0 ? impB[(3 * 64 + q) * 33 + j] : 0.f));
            if (j == 0 || j == tq || j == tq - 1) x = 1e4f;
            xv[jj] = (j <= tq) ? x : -3e38f; }
        LDS_WAIT();
#pragma unroll
        for (int jj = 0; jj < 4; ++jj) row[4 * part + jj] = xv[jj];
    }
    __syncthreads();
    {
        const int q = tid & 63, part = tid >> 6;
        const LAS float* row = impA + q * 33;
        float vj[4]; int rk[4];
#pragma unroll
        for (int jj = 0; jj < 4; ++jj) { vj[jj] = row[4 * part + jj]; rk[jj] = 0; }
#pragma unroll 8
        for (int j2 = 0; j2 < 32; ++j2) { const float v2 = row[j2];
#pragma unroll
            for (int jj = 0; jj < 4; ++jj) rk[jj] += (v2 > vj[jj] || (v2 == vj[jj] && j2 < 4 * part + jj)) ? 1 : 0; }
        unsigned bits = 0u;
#pragma unroll
        for (int jj = 0; jj < 4; ++jj) { const int jb = 4 * part + jj; if (rk[jj] < 8 && jb <= tq) bits |= 1u << jb; }
        if (bits) { atomicOr((unsigned*)selq_l + q, bits); atomicOr((unsigned*)selu_l, bits); }
    }
    __syncthreads();
    const unsigned selq = selq_l[ql]; const unsigned selu = selu_l[0];
    {
        PolSel ps; ps.zb = zb; ps.t = t; ps.hi = hi; ps.selq = selq; ps.c2 = c2;
        float m_run = -1e20f, l_run = 0.f; f32x16 o[2];
#pragma unroll
        for (int r = 0; r < 16; ++r) { o[0][r] = 0.f; o[1][r] = 0.f; }
        flash_run<64, PolSel>(lds, ps, selu, qf, m_run, l_run, o, tid);
        const float lt = l_run + xchg32(l_run); const float w = lt > 0.f ? g1 / lt : 0.f;
#pragma unroll
        for (int r = 0; r < 16; ++r) { ot[0][r] += w * o[0][r]; ot[1][r] += w * o[1][r]; }
    }
    {
        PolWin pw; pw.zb = zb; pw.t = t; pw.hi = hi; pw.w0 = tq * 64 + (wave & 1) * 32; pw.c2 = c2;
        float m_run = -1e20f, l_run = 0.f; f32x16 o[2];
#pragma unroll
        for (int r = 0; r < 16; ++r) { o[0][r] = 0.f; o[1][r] = 0.f; }
        const int lo = tq >= 8 ? tq - 8 : 0;
        const unsigned tmask = ((tq == 31) ? 0xffffffffu : ((1u << (tq + 1)) - 1u)) & ~((1u << lo) - 1u);
        flash_run<64, PolWin>(lds, pw, tmask, qf, m_run, l_run, o, tid);
        const float lt = l_run + xchg32(l_run); const float w = lt > 0.f ? g2 / lt : 0.f;
#pragma unroll
        for (int r = 0; r < 16; ++r) { ot[0][r] += w * o[0][r]; ot[1][r] += w * o[1][r]; }
    }
    store_o(O + (size_t)(b * SEQ + t) * DM + 256 + h * 64, ot, 1.f, hi);
}
}


__device__ __forceinline__ void row_bf16_sq(const float* xrow, bf16_t* orow, float* sqp, int lane) {
    const f32x4* xr = (const f32x4*)xrow + lane;
    f32x4 v[4]; float s = 0.f;
#pragma unroll
    for (int j = 0; j < 4; ++j) { v[j] = xr[64 * j]; s += (v[j].x * v[j].x + v[j].y * v[j].y) + (v[j].z * v[j].z + v[j].w * v[j].w); }
    s = wave_sum(s);
    unsigned long long* o8 = (unsigned long long*)orow + lane;
#pragma unroll
    for (int j = 0; j < 4; ++j) o8[64 * j] = (unsigned long long)pk2(v[j].x, v[j].y) | ((unsigned long long)pk2(v[j].z, v[j].w) << 32);
    if (lane == 0) *sqp = s;
}

__device__ __forceinline__ int att_unit_cost(int u) {
    const int ty = u >> 8, k = u & 255;
    if (ty == 0) return 10 * ((k & 7) + 1);
    if (ty == 1) return 0;
    const int tq1 = (k & 31) + 1;
    if (ty == 2) return 2 * tq1;
    return 2 * (6 + (tq1 < 14 ? tq1 : 14) + (tq1 < 9 ? tq1 : 9));
}
#define XB_TMO      128
#define XB_XCNT(j)  (256  + 64 * (j))
#define XB_XSUB(j)  (1280 + 64 * (j))
#define XB_XGEN(j)  (2304 + 64 * (j))
#define XB_TOP      3328
#define XB_TOPGEN   3392
#define XCD_BAR_WORDS 3456
#define XB_SPIN_CAP (1u << 18)
__device__ __forceinline__ unsigned xb_ld(unsigned* p)              { return __hip_atomic_load(p, __ATOMIC_RELAXED, __HIP_MEMORY_SCOPE_AGENT); }
__device__ __forceinline__ unsigned xb_add(unsigned* p, unsigned v) { return __hip_atomic_fetch_add(p, v, __ATOMIC_RELAXED, __HIP_MEMORY_SCOPE_AGENT); }
__device__ __forceinline__ unsigned xb_xcc_id() { return (unsigned)__builtin_amdgcn_s_getreg((3 << 11) | 20) & 0xFu; }
#define XB_SPIN(cond, bar) do { unsigned _sp = 0; while (cond) { __builtin_amdgcn_s_sleep(1); \
    if ((++_sp & 255u) == 0u) { if (xb_ld(&(bar)[XB_TMO])) break; if (_sp > XB_SPIN_CAP) { atomicAdd(&(bar)[XB_TMO], 1u); break; } } } } while (0)
struct XcdBarrier { unsigned* bar; unsigned x; volatile LAS unsigned* st; };
__device__ __forceinline__ XcdBarrier xcd_barrier_post(unsigned* bar, volatile LAS unsigned* st) {
    XcdBarrier b; b.bar = bar; b.x = xb_xcc_id(); b.st = st;
    if (threadIdx.x == 0) (void)xb_add(&bar[XB_XCNT(b.x)], 1u);
    return b;
}
__device__ __forceinline__ void xcd_barrier_complete(unsigned* bar, unsigned x, unsigned& nloc, unsigned& nx) {
    const unsigned G = gridDim.x * gridDim.y * gridDim.z;
    unsigned sum, cnt, mine, sp = 0u;
    for (;;) {
        sum = 0u; cnt = 0u; mine = 0u;
#pragma unroll
        for (unsigned j = 0; j < 16; ++j) { const unsigned c = xb_ld(&bar[XB_XCNT(j)]); sum += c; cnt += (c > 0u) ? 1u : 0u; mine = (j == x) ? c : mine; }
        if (sum == G) break;
        __builtin_amdgcn_s_sleep(1);
        if ((++sp & 255u) == 0u) { if (xb_ld(&bar[XB_TMO])) break; if (sp > XB_SPIN_CAP) { atomicAdd(&bar[XB_TMO], 1u); break; } }
    }
    nloc = mine > 0u ? mine : 1u; nx = cnt > 0u ? cnt : 1u;
}
__device__ __forceinline__ void xcd_barrier(const XcdBarrier& b) {
    asm volatile("s_waitcnt vmcnt(0)" ::: "memory");
    __syncthreads();
    if (threadIdx.x == 0) {
        unsigned* bar = b.bar;
        __builtin_amdgcn_s_waitcnt(0);
        unsigned nloc = b.st[0], nx = b.st[1];
        if (nloc == 0u) { xcd_barrier_complete(bar, b.x, nloc, nx); b.st[0] = nloc; b.st[1] = nx; }
        const unsigned old = xb_add(&bar[XB_XSUB(b.x)], 1u);
        const unsigned gen = old / nloc;
        if (old + 1u == (gen + 1u) * nloc) {
            __builtin_amdgcn_fence(__ATOMIC_RELEASE, "agent");
            asm volatile("s_waitcnt vmcnt(0)" ::: "memory");
            const unsigned og = xb_add(&bar[XB_TOP], 1u);
            const unsigned tg = og / nx;
            if (og + 1u == (tg + 1u) * nx) xb_add(&bar[XB_TOPGEN], 1u);
            else XB_SPIN(xb_ld(&bar[XB_TOPGEN]) == tg, bar);
            __builtin_amdgcn_fence(__ATOMIC_ACQUIRE, "agent");
            xb_add(&bar[XB_XGEN(b.x)], 1u);
            asm volatile("s_waitcnt vmcnt(0)" ::: "memory");
        } else {
            XB_SPIN(xb_ld(&bar[XB_XGEN(b.x)]) == gen, bar);
            __builtin_amdgcn_fence(__ATOMIC_ACQUIRE, "agent");
            asm volatile("s_waitcnt vmcnt(0)" ::: "memory");
        }
    }
    __syncthreads();
}
constexpr int LDS_XB_OFF = 131072 + 512;
constexpr size_t WS_BAR = 65536;
constexpr size_t WS_SQ = 131072;

#define CAS __attribute__((address_space(4)))
#define ARGS() (*({ const CAS Args* p_ = (const CAS Args*)__builtin_amdgcn_kernarg_segment_ptr(); asm volatile("" : "+s"(p_)); p_; }))
__global__ void __launch_bounds__(512, 2) fwd_kernel(Args a_unused) {
    extern __shared__ __attribute__((aligned(16))) unsigned char lds_raw[];
    LAS unsigned char* lds = (LAS unsigned char*)lds_raw;
    cg::grid_group grid = cg::this_grid();
    { volatile LAS unsigned* stw = (volatile LAS unsigned*)(lds + LDS_XB_OFF); if (threadIdx.x < 4) stw[threadIdx.x] = 0u; }
    __syncthreads();
    const XcdBarrier xbar = xcd_barrier_post((unsigned*)(ARGS().ws + WS_BAR), (volatile LAS unsigned*)(lds + LDS_XB_OFF));
    grid.sync();
#define GSYNC() xcd_barrier(xbar)
    const int G = gridDim.x, NGW = G * 8;
#define ws (ARGS().ws)
#define H ((bf16_t*)(ws + WS_H))
#define Z ((bf16_t*)(ws + WS_Z))
#define O ((bf16_t*)(ws + WS_O))
#define GATE ((bf16_t*)(ws + WS_GATE))
#define HID ((bf16_t*)(ws + WS_HID))

    for (int l = 0; l < DEPTH; ++l) {
        const float* xin = (l == 0) ? ARGS().x : ARGS().out;
        int tid = threadIdx.x; asm volatile("" : "+v"(tid));
        int bx = blockIdx.x; asm volatile("" : "+s"(bx));
        const int lane = tid & 63, wave = __builtin_amdgcn_readfirstlane(tid >> 6), gw = bx * 8 + wave;
        p0_weights(ARGS(), l, lds, gw, NGW, lane, wave, (G == 256) ? 0 : 2);
        if (l == 0 && gw < 1024) {
            const int cu = att_unit_cost(gw); int r = 0;
            for (int v = lane; v < 1024; v += 64) { const int cv = att_unit_cost(v); r += (cv > cu || (cv == cu && v < gw)) ? 1 : 0; }
            r = (int)wred_add((unsigned)r);
            if (lane == 0) ((unsigned short*)(ws + 16384))[r] = (unsigned short)gw;
        }
        if (l == 0) { float* SQ = (float*)(ws + WS_SQ); for (int m = gw; m < NTOK; m += NGW) row_bf16_sq(xin + (size_t)m * DM, H + (size_t)m * DM, SQ + m, lane); }
        GSYNC();
        { pg8::Gemm g{H, (const bf16_t*)(ws + WS_WZ), NTOK, ZW, DM, DM, DM}; pg8::StaticOrder S; S.init(NTOK, ZW, G, bx);
          pg8::EpiBf16<0> E{Z, ZW, ZW, (const float*)(ws + WS_SQ) + (size_t)(2 * l) * NTOK}; pg8::gemm_phase(lds, g, S, E); }
        if (G == 256 && bx >= 128) p0_weights(ARGS(), l, lds, (bx - 128) * 8 + wave, 128 * 8, lane, wave, 1);
        GSYNC();
        { bf16_t* KCC = (bf16_t*)(ws + WS_KCC); bf16_t* VCC = (bf16_t*)(ws + WS_VCC); float* FC = (float*)(ws + WS_FOXC); const CAS Args& a = ARGS();
          if (gw < 32) fox_scan(ARGS(), l, Z, FC, gw, lane);
          if (NTOK % (4 * NGW) == 0) { for (int m = gw; m < NTOK; m += 4 * NGW) prep_tokens<4>(a, l, Z, KCC, VCC, m, NGW, lane); }
          else { for (int m = gw; m < NTOK; m += NGW) prep_tokens<1>(a, l, Z, KCC, VCC, m, NGW, lane); } }
        GSYNC();
        { bf16_t* QKVM = (bf16_t*)(ws + WS_QKVM);
          pg8::Gemm g{Z, (const bf16_t*)(ws + WS_WMLA), NTOK, 1024, 384, ZW, 384}; pg8::StaticOrder S; S.init(NTOK, 1024, G, bx);
          pg8::EpiBf16<0> E{QKVM, 1024, 1024, nullptr}; pg8::gemm_phase(lds, g, S, E);
          { pg8::Gemm gk{(const bf16_t*)(ws + WS_KCC), (const bf16_t*)(ws + WS_WCMP), 1024, 256, 2048, 1024, 2048}; pg8::StaticOrder Sk; Sk.init(1024, 256, G, bx);
            pg8::EpiCmp Ek{(bf16_t*)(ws + WS_KCMP), (const float*)(ws + WS_CMPB)}; pg8::gemm_phase(lds, gk, Sk, Ek);
            pg8::Gemm gv{(const bf16_t*)(ws + WS_VCC), (const bf16_t*)(ws + WS_WCMP) + (size_t)256 * 2048, 1024, 256, 2048, 1024, 2048}; pg8::StaticOrder Sv; Sv.init(1024, 256, G, (bx + G - 4) % G);
            pg8::EpiCmp Ev{(bf16_t*)(ws + WS_VCMP), (const float*)(ws + WS_CMPB) + 64}; pg8::gemm_phase(lds, gv, Sv, Ev); }
          unsigned long long* SELM = (unsigned long long*)(ws + WS_SELM);
          { unsigned* qctr = (unsigned*)(ws + 8192) + (2 + l) * 64; LAS unsigned* qslot = (LAS unsigned*)(lds + 131072 + 768);
            for (;;) {
                __syncthreads();
                if (tid == 0) qslot[0] = __hip_atomic_fetch_add(qctr, 1u, __ATOMIC_RELAXED, __HIP_MEMORY_SCOPE_AGENT);
                __syncthreads();
                const int idx = (int)qslot[0];
                if (idx >= 1280) break;
                int tid_i = tid; asm volatile("" : "+v"(tid_i));
                if (idx >= 256) { const int k = idx - 256; att::dsa_index_unit(lds, Z, SELM, k & 7, 127 - (k >> 3), tid_i); }
                else { att::fox_unit(lds, Z, (const float*)(ws + WS_FOXC), O, (idx >> 2) & 7, idx & 3, 7 - (idx >> 5), tid_i); }
            } } }
        GSYNC();
        { const float* FC = (const float*)(ws + WS_FOXC); const bf16_t* QKVM = (const bf16_t*)(ws + WS_QKVM); const unsigned long long* SELM = (const unsigned long long*)(ws + WS_SELM);
          unsigned* qctr = (unsigned*)(ws + 8192) + l * 64;
          LAS unsigned* qslot = (LAS unsigned*)(lds + 131072 + 768);
          for (;;) {
              __syncthreads();
              if (tid == 0) qslot[0] = __hip_atomic_fetch_add(qctr, 1u, __ATOMIC_RELAXED, __HIP_MEMORY_SCOPE_AGENT);
              __syncthreads();
              const int idx = (int)qslot[0];
              if (idx >= 768) break;
              const int uid = (int)((const unsigned short*)(ws + 16384))[idx]; const int ty = uid >> 8, k = uid & 255;
              int tid_i = tid; asm volatile("" : "+v"(tid_i));
              if (ty == 0) att::mla_unit(lds, QKVM, Z, ARGS().pos, O, k >> 5, (k >> 3) & 3, k & 7, tid_i);
              else if (ty == 1) att::fox_unit(lds, Z, FC, O, k >> 5, (k >> 3) & 3, k & 7, tid_i);
              else if (ty == 2) att::dsa_unit(lds, Z, SELM, O, k >> 5, k & 31, tid_i);
              else att::nsa_unit(lds, Z, (const bf16_t*)(ws + WS_KCMP), (const bf16_t*)(ws + WS_VCMP), O, k >> 5, k & 31, tid_i);
          } }
        GSYNC();
        { pg8::Gemm g{H, (const bf16_t*)(ws + WS_WG), NTOK, 4096, DM, DM, DM};
          const int vcu = (G % 8 == 0) ? (bx % 8) * (G / 8) + bx / 8 : bx;
          pg8::FusedOrder S{G, vcu, (const char*)O, (const char*)(ws + WS_WBR2), (const char*)H, (const char*)(ws + WS_WG)};
          pg8::EpiFused E{GATE + (size_t)bx * 65536, Z, (const float*)(ws + WS_SQ) + (size_t)(2 * l) * NTOK}; pg8::gemm_phase(lds, g, S, E); }
        GSYNC();
        { pg8::Gemm g{Z, (const bf16_t*)(ws + WS_WOUT4), NTOK, DM, DM, DM, DM}; pg8::StaticOrder S; S.init(NTOK, DM, G, bx);
          pg8::EpiResid E{xin, ARGS().out, DM, H, (float*)(ws + WS_SQ) + (size_t)(2 * l + 1) * NTOK}; pg8::gemm_phase(lds, g, S, E); }
        GSYNC();
        { pg8::Gemm g{H, (const bf16_t*)(ws + WS_WUP), NTOK, DFF, DM, DM, DM}; pg8::StaticOrder S; S.init(NTOK, DFF, G, bx);
          pg8::EpiBf16<2> E{HID, DFF, DFF, (const float*)(ws + WS_SQ) + (size_t)(2 * l + 1) * NTOK}; pg8::gemm_phase(lds, g, S, E); }
        GSYNC();
        { pg8::Gemm g{HID, (const bf16_t*)(ws + WS_WDN), NTOK, DM, DFF, DFF, DFF}; pg8::StaticOrder S; S.init(NTOK, DM, G, bx);
          float* xo = ARGS().out; pg8::EpiResid E{xo, xo, DM, H, (float*)(ws + WS_SQ) + (size_t)(2 * l + 2) * NTOK}; pg8::gemm_phase(lds, g, S, E); }
        GSYNC();
    }
    { const int tid = threadIdx.x, lane = tid & 63, wave = __builtin_amdgcn_readfirstlane(tid >> 6), gw = blockIdx.x * 8 + wave;
      for (int m = gw; m < NTOK; m += NGW) rms_row_f32(ARGS().out + (size_t)m * DM, ARGS().final_g, lane); }
}

#undef ws
#undef H
#undef Z
#undef O
#undef GATE
#undef HID
extern "C" void kernel_launch(void* const* d_in, const int* in_sizes, int n_in, void* d_out, int out_size, void* d_ws, size_t ws_size, hipStream_t stream) {
    static int grid = 0;
    if (grid == 0) {
        int dev = 0, cus = 0, per_cu = 0;
        hipGetDevice(&dev);
        hipDeviceGetAttribute(&cus, hipDeviceAttributeMultiprocessorCount, dev);
        hipFuncSetAttribute((const void*)fwd_kernel, hipFuncAttributeMaxDynamicSharedMemorySize, LDS_BYTES);
        hipOccupancyMaxActiveBlocksPerMultiprocessor(&per_cu, (const void*)fwd_kernel, 512, LDS_BYTES);
        if (per_cu < 1) { fprintf(stderr, "occupancy query returned %d\n", per_cu); per_cu = 1; }
        grid = cus * 1;
        if (ws_size < WS_END) { fprintf(stderr, "workspace too small: %zu\n", ws_size); grid = -1; }
    }
    if (grid < 0) return;
    if (hipMemsetAsync(d_ws, 0, 131072 + 5 * 65536, stream) != hipSuccess) { fprintf(stderr, "memset failed\n"); return; }
    Args a{};
    a.x = (const float*)d_in[0]; a.pos = (const int*)d_in[1]; a.norm1_g = (const float*)d_in[2]; a.w_in = (const float*)d_in[3];
    a.mla_qg = (const float*)d_in[4]; a.mla_wuq = (const float*)d_in[5]; a.mla_kvg = (const float*)d_in[6]; a.mla_wukv = (const float*)d_in[7];
    a.cmp_pe = (const float*)d_in[8]; a.cmp_w = (const float*)d_in[9]; a.fox_fb = (const float*)d_in[10]; a.w_branch = (const float*)d_in[11];
    a.w_out = (const float*)d_in[12]; a.norm2_g = (const float*)d_in[13]; a.w_up = (const float*)d_in[14]; a.w_down = (const float*)d_in[15]; a.final_g = (const float*)d_in[16];
    a.out = (float*)d_out; a.ws = (unsigned char*)d_ws;
    void* args[] = {&a};
    hipError_t e = hipLaunchCooperativeKernel((const void*)fwd_kernel, dim3(grid), dim3(512), args, LDS_BYTES, stream);
    if (e != hipSuccess) fprintf(stderr, "cooperative launch failed: %s (grid %d)\n", hipGetErrorString(e), grid);
}
```

```cpp
#include <hip/hip_runtime.h>
#include <hip/hip_cooperative_groups.h>
#include <cstdio>
#include <cstdint>
namespace cg = cooperative_groups;

#define LAS __attribute__((address_space(3)))
typedef unsigned short bf16_t;
typedef short bf16x8 __attribute__((ext_vector_type(8)));
typedef float f32x4 __attribute__((ext_vector_type(4)));
typedef float f32x16 __attribute__((ext_vector_type(16)));
typedef unsigned u32x4 __attribute__((ext_vector_type(4)));
typedef unsigned u32x2 __attribute__((ext_vector_type(2)));

constexpr int DM = 1024, NB = 8, SEQ = 2048, NTOK = NB * SEQ, DFF = 4096, INC = 6616, ZW = 2560, DEPTH = 2;
constexpr int ZC_CQ = 0, ZC_CKV = 256, ZC_KR = 384, ZC_NQ = 416, ZC_NKC = 672, ZC_NVC = 736, ZC_NKS = 800, ZC_NVS = 864, ZC_NKW = 928, ZC_NVW = 992,
              ZC_FQ = 1056, ZC_FK = 1312, ZC_FV = 1568, ZC_DQ = 1824, ZC_DK = 2080, ZC_DV = 2144, ZC_DQI = 2208, ZC_DKI = 2464,
              ZC_NG = 2496, ZC_FF = 2508, ZC_DW = 2512;
constexpr float NORM_EPS = 1e-6f, NEGF = -1e30f, LOG2E = 1.4426950408889634f;

constexpr size_t MiB = 1u << 20;
constexpr size_t WS_CTL = 0;
constexpr size_t WS_WZ = 1 * MiB, WS_WG = 6 * MiB, WS_WMLA = 14 * MiB, WS_WCMP = 15 * MiB, WS_WBR = 17 * MiB, WS_WOUT4 = 19 * MiB, WS_WUP = 27 * MiB, WS_WDN = 35 * MiB;
constexpr size_t WS_WBR2 = 246 * MiB;
constexpr size_t WS_FOXC = 43 * MiB, WS_KCMP = 43 * MiB + 256 * 1024, WS_VCMP = 43 * MiB + 512 * 1024, WS_CMPB = 43 * MiB + 768 * 1024;
constexpr size_t WS_KCC = 44 * MiB, WS_VCC = 46 * MiB + 256 * 1024;
constexpr size_t WS_SELM = 49 * MiB, WS_H = 53 * MiB, WS_O = 85 * MiB, WS_QKVM = 117 * MiB, WS_GATE = 117 * MiB, WS_HID = 117 * MiB, WS_Z = 149 * MiB;
constexpr size_t WS_END = 254 * MiB;

constexpr int LDS_BYTES = 147456;

__device__ __forceinline__ unsigned f2bf(float f) { unsigned u = __float_as_uint(f); return (u + 0x7fffu + ((u >> 16) & 1u)) >> 16; }
__device__ __forceinline__ unsigned pk2(float lo, float hi) { return f2bf(lo) | (f2bf(hi) << 16); }
__device__ __forceinline__ float bf2f(unsigned b) { return __uint_as_float(b << 16); }
__device__ __forceinline__ float bflo(unsigned w) { return __uint_as_float(w << 16); }
__device__ __forceinline__ float bfhi(unsigned w) { return __uint_as_float(w & 0xffff0000u); }
typedef float f32x2_t __attribute__((ext_vector_type(2))); typedef __bf16 bf16x2_t __attribute__((ext_vector_type(2)));
__device__ __forceinline__ unsigned cvt_pk_bf16(float lo, float hi) { f32x2_t v = {lo, hi}; bf16x2_t b = __builtin_convertvector(v, bf16x2_t); return __builtin_bit_cast(unsigned, b); }
__device__ __forceinline__ float wave_sum(float v) {
#pragma unroll
    for (int o = 1; o < 64; o <<= 1) v += __shfl_xor(v, o);
    return v;
}

__device__ __forceinline__ float xchg32(float v) { const unsigned u = __float_as_uint(v); const auto rr = __builtin_amdgcn_permlane32_swap(u, u, false, false); return __uint_as_float((threadIdx.x & 32) ? rr[0] : rr[1]); }
__device__ __forceinline__ unsigned wred_add(unsigned v) {
    v += (unsigned)__builtin_amdgcn_update_dpp(0, (int)v, 0x111, 0xf, 0xf, true);
    v += (unsigned)__builtin_amdgcn_update_dpp(0, (int)v, 0x112, 0xf, 0xf, true);
    v += (unsigned)__builtin_amdgcn_update_dpp(0, (int)v, 0x114, 0xf, 0xf, true);
    v += (unsigned)__builtin_amdgcn_update_dpp(0, (int)v, 0x118, 0xf, 0xf, true);
    v += (unsigned)__builtin_amdgcn_update_dpp(0, (int)v, 0x142, 0xa, 0xf, true);
    v += (unsigned)__builtin_amdgcn_update_dpp(0, (int)v, 0x143, 0xc, 0xf, true);
    return (unsigned)__builtin_amdgcn_readlane((int)v, 63);
}
__device__ __forceinline__ unsigned wred_umax(unsigned v) {
    unsigned t;
    t = (unsigned)__builtin_amdgcn_update_dpp(0, (int)v, 0x111, 0xf, 0xf, true); v = t > v ? t : v;
    t = (unsigned)__builtin_amdgcn_update_dpp(0, (int)v, 0x112, 0xf, 0xf, true); v = t > v ? t : v;
    t = (unsigned)__builtin_amdgcn_update_dpp(0, (int)v, 0x114, 0xf, 0xf, true); v = t > v ? t : v;
    t = (unsigned)__builtin_amdgcn_update_dpp(0, (int)v, 0x118, 0xf, 0xf, true); v = t > v ? t : v;
    t = (unsigned)__builtin_amdgcn_update_dpp(0, (int)v, 0x142, 0xa, 0xf, true); v = t > v ? t : v;
    t = (unsigned)__builtin_amdgcn_update_dpp(0, (int)v, 0x143, 0xc, 0xf, true); v = t > v ? t : v;
    return (unsigned)__builtin_amdgcn_readlane((int)v, 63);
}
__device__ __forceinline__ float fmax1(float a, float b) { return __builtin_amdgcn_fmed3f(a, b, __builtin_inff()); }
#define LDS_WAIT() asm volatile("s_waitcnt lgkmcnt(0)" ::: "memory")

namespace pg8 {
constexpr int BM = 256, BK = 64, HALF = 128, HTB = HALF * BK * 2, STAGE_BYTES = 8 * HTB, NXCD = 8, WGM = 8;
__host__ __device__ __forceinline__ int lds_byte(int r, int c) { const int st = (r >> 4) * 2 + (c >> 5), rr = r & 15, cc = c & 31, ob = rr * 64 + cc * 2; return st * 1024 + (ob ^ (((ob >> 9) & 1) << 5)); }
__host__ __device__ __forceinline__ void stage_rc(int b, int& R, int& C) { const int st = b / 1024, sb = b % 1024, swz = sb ^ (((sb >> 9) & 1) << 5); R = (st >> 1) * 16 + swz / 64; C = (st & 1) * 32 + (swz % 64) / 2; }
__host__ __device__ __forceinline__ int perm32(int rho) { const int n = rho >> 4, i = rho & 15; return 8 * (i >> 2) + 4 * n + (i & 3); }

struct Unit { int pm, pn; int aoff; const char* A; const char* B; int nt; int kind; };
struct Gemm { const bf16_t* A; const bf16_t* Bt; int M, N, K, lda, ldb; };

struct StaticOrder {
    int nM, nN, nwg, G, c;
    __device__ void init(int M, int N, int G_, int c_) { nM = M / BM; nN = N / BM; nwg = nM * nN; G = G_; c = c_; }
    __device__ bool next(int i, Unit& u) const {
        const long L = (long)i * G + c; if (L >= nwg) return false;
        int wgid = (int)L; { const int q = nwg / NXCD, r = nwg % NXCD, xcd = wgid % NXCD, off = wgid / NXCD; wgid = (xcd < r ? xcd * (q + 1) : r * (q + 1) + (xcd - r) * q) + off; }
        const int nig = WGM * nN, gid = wgid / nig, fm = gid * WGM, gsz = (nM - fm) < WGM ? (nM - fm) : WGM;
        u.pm = fm + ((wgid % nig) % gsz); u.pn = (wgid % nig) / gsz; u.aoff = 0; u.nt = 0; u.kind = 0; u.A = nullptr; u.B = nullptr; return true;
    }
};

template <int ACT> struct EpiBf16 {
    static constexpr bool PERM = true;
    bf16_t* O; int ldc; int nvalid; const float* sq;
    __device__ __forceinline__ void operator()(const f32x4 (&acc)[2][2][4][2], const Unit& u, int wr, int wc, int fr, int fq) const {
        const int row0 = u.pm * BM + wr * 64 + fr; const int col0 = u.pn * BM + wc * 32 + 8 * fq;
#pragma unroll
        for (int ai = 0; ai < 2; ++ai)
#pragma unroll
            for (int m = 0; m < 4; ++m) { bf16_t* rowp = O + (size_t)(row0 + ai * HALF + m * 16) * ldc + col0;
                const float rs = sq ? 1.0f / sqrtf(sq[row0 + ai * HALF + m * 16] * (1.f / 1024.f) + NORM_EPS) : 1.f;
#pragma unroll
                for (int bj = 0; bj < 2; ++bj) { if (col0 + bj * HALF >= nvalid) continue;
                    f32x4 v0 = acc[ai][bj][m][0] * rs, v1 = acc[ai][bj][m][1] * rs;
                    if (ACT == 1) {
#pragma unroll
                        for (int j = 0; j < 4; ++j) { v0[j] = __builtin_amdgcn_rcpf(1.f + __expf(-v0[j])); v1[j] = __builtin_amdgcn_rcpf(1.f + __expf(-v1[j])); } }
                    if (ACT == 2) {
#pragma unroll
                        for (int j = 0; j < 4; ++j) { float a = fmaxf(v0[j], 0.f), b = fmaxf(v1[j], 0.f); v0[j] = a * a; v1[j] = b * b; } }
                    if (ACT == 3) { const u32x4 g = *(const u32x4*)(rowp + bj * HALF);
                        v0[0] *= bflo(g.x); v0[1] *= bfhi(g.x); v0[2] *= bflo(g.y); v0[3] *= bfhi(g.y);
                        v1[0] *= bflo(g.z); v1[1] *= bfhi(g.z); v1[2] *= bflo(g.w); v1[3] *= bfhi(g.w); }
                    u32x4 w; w.x = cvt_pk_bf16(v0[0], v0[1]); w.y = cvt_pk_bf16(v0[2], v0[3]); w.z = cvt_pk_bf16(v1[0], v1[1]); w.w = cvt_pk_bf16(v1[2], v1[3]);
                    *(u32x4*)(rowp + bj * HALF) = w; }
                asm volatile("" ::: "memory"); }
    }
};
struct EpiResid {
    static constexpr bool PERM = false;
    const float* base; float* out; int ldc; bf16_t* xb; float* sq;
    __device__ __forceinline__ void operator()(const f32x4 (&acc)[2][2][4][2], const Unit& u, int wr, int wc, int fr, int fq) const {
        const int col0 = u.pn * BM + wc * 32 + 4 * fq;
#pragma unroll
        for (int ai = 0; ai < 2; ++ai)
#pragma unroll
            for (int m = 0; m < 4; ++m) { const int row = u.pm * BM + ai * HALF + wr * 64 + m * 16 + fr; const size_t off = (size_t)row * ldc + col0;
                float ss = 0.f;
#pragma unroll
                for (int bj = 0; bj < 2; ++bj)
#pragma unroll
                    for (int n = 0; n < 2; ++n) { const f32x4 bs = *(const f32x4*)(base + off + bj * HALF + n * 16); const f32x4 v = bs + acc[ai][bj][m][n];
                        *(f32x4*)(out + off + bj * HALF + n * 16) = v;
                        u32x2 w; w.x = cvt_pk_bf16(v[0], v[1]); w.y = cvt_pk_bf16(v[2], v[3]); *(u32x2*)(xb + off + bj * HALF + n * 16) = w;
                        ss += (v[0] * v[0] + v[1] * v[1]) + (v[2] * v[2] + v[3] * v[3]); }
                ss += __shfl_xor(ss, 16); ss += __shfl_xor(ss, 32);
                if (fq == 0) atomicAdd(sq + row, ss);
                asm volatile("" ::: "memory"); }
    }
};
struct EpiCmp {
    static constexpr bool PERM = false;
    bf16_t* O; const float* bias;
    __device__ __forceinline__ void operator()(const f32x4 (&acc)[2][2][4][2], const Unit& u, int wr, int wc, int fr, int fq) const {
        if (u.pn != 0 || wc >= 2) return;
#pragma unroll
        for (int ai = 0; ai < 2; ++ai)
#pragma unroll
            for (int m = 0; m < 4; ++m) { const int row = u.pm * BM + ai * HALF + wr * 64 + m * 16 + fr;
#pragma unroll
                for (int n = 0; n < 2; ++n) { const int col = wc * 32 + n * 16 + 4 * fq; const f32x4 a = acc[ai][0][m][n];
                    float v[4];
#pragma unroll
                    for (int j = 0; j < 4; ++j) v[j] = ((row & 127) == 127) ? 0.f : a[j] + bias[col + j];
                    u32x2 w; w.x = pk2(v[0], v[1]); w.y = pk2(v[2], v[3]); *(u32x2*)(O + (size_t)row * 64 + col) = w; } }
    }
};


struct LiftOrder {
    StaticOrder so; int c;
    __device__ void init(int G_, int c_) { so.init(16384, 4096, G_, c_); c = c_; }
    __device__ bool next(int i, Unit& u) const { StaticOrder t = so; t.c = c; if (!t.next(i, u)) return false; u.aoff = (u.pn >> 2) * 512; return true; }
};
struct GroupOrder {
    int G, c;
    __device__ bool next(int i, Unit& u) const { const int grp = c + (i >> 2) * G; if (grp >= 256) return false; u.pm = grp >> 2; u.pn = (i & 3) * 4 + (grp & 3); u.aoff = 0; u.nt = 0; u.kind = 0; u.A = nullptr; u.B = nullptr; return true; }
};
__device__ __forceinline__ u32x4 load_sc(const bf16_t* p) { u32x4 v; asm volatile("global_load_dwordx4 %0, %1, off sc0 sc1\n\ts_waitcnt vmcnt(0)" : "=v"(v) : "v"(p) : "memory"); return v; }
struct EpiGateMix {
    static constexpr bool PERM = true;
    const bf16_t* L; bf16_t* MIX; const float* sq;
    __device__ __forceinline__ void operator()(const f32x4 (&acc)[2][2][4][2], const Unit& u, int wr, int wc, int fr, int fq) const {
        const int br = u.pn >> 2, pd = u.pn & 3;
        const int row0 = u.pm * BM + wr * 64 + fr; const int colL = u.pn * BM + wc * 32 + 8 * fq, colM = pd * BM + wc * 32 + 8 * fq;
#pragma unroll
        for (int ai = 0; ai < 2; ++ai)
#pragma unroll
            for (int m = 0; m < 4; ++m) { const size_t row = (size_t)(row0 + ai * HALF + m * 16);
                const float rs = 1.0f / sqrtf(sq[row] * (1.f / 1024.f) + NORM_EPS);
#pragma unroll
                for (int bj = 0; bj < 2; ++bj) {
                    const u32x4 g = *(const u32x4*)(L + row * 4096 + colL + bj * HALF);
                    f32x4 v0 = acc[ai][bj][m][0] * rs, v1 = acc[ai][bj][m][1] * rs;
#pragma unroll
                    for (int j = 0; j < 4; ++j) { v0[j] = __builtin_amdgcn_rcpf(1.f + __expf(-v0[j])); v1[j] = __builtin_amdgcn_rcpf(1.f + __expf(-v1[j])); }
                    v0[0] *= bflo(g.x); v0[1] *= bfhi(g.x); v0[2] *= bflo(g.y); v0[3] *= bfhi(g.y);
                    v1[0] *= bflo(g.z); v1[1] *= bfhi(g.z); v1[2] *= bflo(g.w); v1[3] *= bfhi(g.w);
                    bf16_t* mp = MIX + row * 1024 + colM + bj * HALF;
                    if (br > 0) { const u32x4 p = *(const u32x4*)mp;
                        v0[0] += bflo(p.x); v0[1] += bfhi(p.x); v0[2] += bflo(p.y); v0[3] += bfhi(p.y);
                        v1[0] += bflo(p.z); v1[1] += bfhi(p.z); v1[2] += bflo(p.w); v1[3] += bfhi(p.w); }
                    u32x4 w; w.x = cvt_pk_bf16(v0[0], v0[1]); w.y = cvt_pk_bf16(v0[2], v0[3]); w.z = cvt_pk_bf16(v1[0], v1[1]); w.w = cvt_pk_bf16(v1[2], v1[3]);
                    *(u32x4*)mp = w; }
                asm volatile("" ::: "memory"); }
    }
};


struct FusedOrder {
    int G, c; const char* Ob; const char* Wb; const char* Hb; const char* Wg;
    __device__ bool next(int i, Unit& u) const {
        const int grp = c + (i >> 3) * G; if (grp >= 256) return false;
        const int br = (i >> 1) & 3, pd = grp & 3; u.pm = grp >> 2; u.pn = br * 4 + pd; u.aoff = 0; u.kind = i & 1;
        if (u.kind == 0) { u.A = Ob + (size_t)u.pm * (256 * 1024 * 2) + br * 512; u.B = Wb + (size_t)u.pn * (256 * 1024 * 2); u.nt = 4; }
        else { u.A = Hb + (size_t)u.pm * (256 * 1024 * 2); u.B = Wg + (size_t)u.pn * (256 * 1024 * 2); u.nt = 16; }
        return true;
    }
};
struct EpiFused {
    static constexpr bool PERM = true;
    bf16_t* park; bf16_t* MIX; const float* sq;
    __device__ __forceinline__ void operator()(const f32x4 (&acc)[2][2][4][2], const Unit& u, int wr, int wc, int fr, int fq) const {
        const int br = u.pn >> 2, pd = u.pn & 3;
        const int rl0 = wr * 64 + fr, cl0 = wc * 32 + 8 * fq;
        const unsigned toff = (unsigned)(((wr * 4 + wc) * 64 + fq * 16 + fr) * 16);
        if (u.kind == 0) {
#pragma unroll
            for (int ai = 0; ai < 2; ++ai)
#pragma unroll
                for (int m = 0; m < 4; ++m) { char* pk2_ = (char*)park + toff; asm volatile("" : "+v"(pk2_));
#pragma unroll
                    for (int bj = 0; bj < 2; ++bj) { const f32x4 v0 = acc[ai][bj][m][0], v1 = acc[ai][bj][m][1];
                        u32x4 w; w.x = cvt_pk_bf16(v0[0], v0[1]); w.y = cvt_pk_bf16(v0[2], v0[3]); w.z = cvt_pk_bf16(v1[0], v1[1]); w.w = cvt_pk_bf16(v1[2], v1[3]);
                        *(u32x4*)(pk2_ + ((ai * 4 + m) * 2 + bj) * 8192) = w; }
                    asm volatile("" ::: "memory"); }
            return;
        }
#pragma unroll
        for (int ai = 0; ai < 2; ++ai)
#pragma unroll
            for (int m = 0; m < 4; ++m) { const int rl = rl0 + ai * HALF + m * 16; const size_t row = (size_t)(u.pm * BM + rl);
                const float rs = 1.0f / sqrtf(sq[row] * (1.f / 1024.f) + NORM_EPS);
                const char* pk2_ = (const char*)park + toff; asm volatile("" : "+v"(pk2_));
#pragma unroll
                for (int bj = 0; bj < 2; ++bj) {
                    const u32x4 g = *(const u32x4*)(pk2_ + ((ai * 4 + m) * 2 + bj) * 8192);
                    f32x4 v0 = acc[ai][bj][m][0] * rs, v1 = acc[ai][bj][m][1] * rs;
#pragma unroll
                    for (int j = 0; j < 4; ++j) { v0[j] = __builtin_amdgcn_rcpf(1.f + __expf(-v0[j])); v1[j] = __builtin_amdgcn_rcpf(1.f + __expf(-v1[j])); }
                    v0[0] *= bflo(g.x); v0[1] *= bfhi(g.x); v0[2] *= bflo(g.y); v0[3] *= bfhi(g.y);
                    v1[0] *= bflo(g.z); v1[1] *= bfhi(g.z); v1[2] *= bflo(g.w); v1[3] *= bfhi(g.w);
                    bf16_t* mp = MIX + row * 1024 + pd * BM + cl0 + bj * HALF;
                    if (br > 0) { const u32x4 p = *(const u32x4*)mp;
                        v0[0] += bflo(p.x); v0[1] += bfhi(p.x); v0[2] += bflo(p.y); v0[3] += bfhi(p.y);
                        v1[0] += bflo(p.z); v1[1] += bfhi(p.z); v1[2] += bflo(p.w); v1[3] += bfhi(p.w); }
                    u32x4 w; w.x = cvt_pk_bf16(v0[0], v0[1]); w.y = cvt_pk_bf16(v0[2], v0[3]); w.z = cvt_pk_bf16(v1[0], v1[1]); w.w = cvt_pk_bf16(v1[2], v1[3]);
                    *(u32x4*)mp = w; }
                asm volatile("" ::: "memory"); }
    }
};

template <class Epi, class Sched>
__device__ __forceinline__ void gemm_phase(LAS unsigned char* lds, const Gemm g, const Sched& S_in, const Epi& E) {
    int tid = threadIdx.x; asm volatile("" : "+v"(tid));
    const int wid = __builtin_amdgcn_readfirstlane(tid >> 6), lane = tid & 63, wr = wid >> 2, wc = wid & 3, fr = lane & 15, fq = lane >> 4;
    int K = g.K; asm volatile("" : "+s"(K)); const int nt_def = K / BK;
    unsigned voffA[2], voffB[2];
#pragma unroll
    for (int i = 0; i < 2; ++i) { int R, C; stage_rc(tid * 16 + i * 8192, R, C); const int Rb = Epi::PERM ? ((R & ~31) + perm32(R & 31)) : R;
        voffA[i] = (unsigned)(R * g.lda + C) * 2u; voffB[i] = (unsigned)(Rb * g.ldb + C) * 2u; }
    const size_t kstep = (size_t)(BK * 2);
    const size_t hsA = (size_t)HALF * g.lda * 2, hsB = (size_t)HALF * g.ldb * 2;
    const size_t tsA = 2 * hsA, tsB = 2 * hsB;
    const unsigned ldsw = (unsigned)wid * 1024u;
    const int aoff = lds_byte(wr * 64 + fr, fq * 8), boff = lds_byte(wc * 32 + fr, fq * 8);
#define PG8_SA(b, h) (((b) * 2 + (h)) * HTB)
#define PG8_SB(b, h) ((4 + (b) * 2 + (h)) * HTB)
#define PG8_STAGE(bufoff, gbase, voff) do { _Pragma("unroll") for (int _i = 0; _i < 2; ++_i) \
        __builtin_amdgcn_global_load_lds((const unsigned*)((const char*)(gbase) + (voff)[_i]), (LAS unsigned*)(lds + (bufoff) + ldsw + _i * 8192), 16, 0, 0); } while (0)
#define PG8_LDA(dst, b, h) do { _Pragma("unroll") for (int m = 0; m < 4; ++m) _Pragma("unroll") for (int k = 0; k < 2; ++k) dst[m][k] = *(const LAS bf16x8*)(lds + PG8_SA(b, h) + aoff + m * 2048 + k * 1024); } while (0)
#define PG8_LDB(dst, b, h) do { _Pragma("unroll") for (int n = 0; n < 2; ++n) _Pragma("unroll") for (int k = 0; k < 2; ++k) dst[n][k] = *(const LAS bf16x8*)(lds + PG8_SB(b, h) + boff + n * 2048 + k * 1024); } while (0)
#define PG8_MMA(ai, bj, At, Bt) do { __builtin_amdgcn_s_setprio(1); _Pragma("unroll") for (int m = 0; m < 4; ++m) _Pragma("unroll") for (int n = 0; n < 2; ++n) _Pragma("unroll") for (int k = 0; k < 2; ++k) \
        acc[ai][bj][m][n] = __builtin_amdgcn_mfma_f32_16x16x32_bf16(Bt[n][k], At[m][k], acc[ai][bj][m][n], 0, 0, 0); __builtin_amdgcn_s_setprio(0); } while (0)
#define PG8_WAIT_V(n) asm volatile("s_waitcnt vmcnt(" #n ")" ::: "memory")
#define PG8_WAIT_L(n) asm volatile("s_waitcnt lgkmcnt(" #n ")" ::: "memory")
#define PG8_BAR __builtin_amdgcn_s_barrier()
#define PG8_SCHED __builtin_amdgcn_sched_barrier(0)
    Sched S = S_in; asm volatile("" : "+s"(S.c));
    Unit cur, nxt; int ui = 0;
    if (!S.next(0, cur)) return;
#define PG8_RESOLVE(u) do { if ((u).nt == 0) { (u).A = (const char*)g.A + (size_t)(u).pm * tsA + (u).aoff; (u).B = (const char*)g.Bt + (size_t)(u).pn * tsB; (u).nt = nt_def; } } while (0)
    PG8_RESOLVE(cur);
    f32x4 acc[2][2][4][2];
#pragma unroll
    for (int a = 0; a < 2; ++a)
#pragma unroll
        for (int b = 0; b < 2; ++b)
#pragma unroll
            for (int m = 0; m < 4; ++m)
#pragma unroll
                for (int n = 0; n < 2; ++n) acc[a][b][m][n] = (f32x4){0.f, 0.f, 0.f, 0.f};
    bf16x8 At[4][2], B0[2][2], B1[2][2];
    const char* cA = cur.A; const char* cB = cur.B;
    {
        PG8_STAGE(PG8_SB(0, 0), cB, voffB); PG8_STAGE(PG8_SB(0, 1), cB + hsB, voffB); PG8_STAGE(PG8_SA(0, 0), cA, voffA); PG8_STAGE(PG8_SA(0, 1), cA + hsA, voffA);
        if (wr == 1) PG8_BAR;
        PG8_WAIT_V(2); PG8_BAR;
        PG8_STAGE(PG8_SB(1, 0), cB + kstep, voffB); PG8_STAGE(PG8_SA(1, 0), cA + kstep, voffA); PG8_STAGE(PG8_SB(1, 1), cB + hsB + kstep, voffB);
        PG8_WAIT_V(6); PG8_BAR;
    }
    for (;;) {
        const bool has_next = S.next(ui + 1, nxt);
        if (has_next) PG8_RESOLVE(nxt);
        const char* nA = has_next ? nxt.A : cA; const char* nB = has_next ? nxt.B : cB;
        const int nt = cur.nt;
        for (int t = 0; t < nt; t += 2) {
            const bool last = (t == nt - 2);
            const char* a1 = cA + (size_t)(t + 1) * kstep;
            const char* a2 = last ? nA : cA + (size_t)(t + 2) * kstep; const char* b2 = last ? nB : cB + (size_t)(t + 2) * kstep;
            const char* a3 = a2 + kstep; const char* b3 = b2 + kstep;
            PG8_LDB(B0, 0, 0); PG8_LDB(B1, 0, 1); PG8_SCHED; PG8_LDA(At, 0, 0); PG8_STAGE(PG8_SA(1, 1), a1 + hsA, voffA);
            PG8_WAIT_V(8); PG8_WAIT_L(0); PG8_BAR; PG8_MMA(0, 0, At, B0); PG8_MMA(0, 1, At, B1); PG8_BAR; PG8_SCHED;
            PG8_LDA(At, 0, 1); PG8_STAGE(PG8_SB(0, 0), b2, voffB); PG8_STAGE(PG8_SB(0, 1), b2 + hsB, voffB); PG8_STAGE(PG8_SA(0, 0), a2, voffA);
            PG8_WAIT_V(8); PG8_WAIT_L(0); PG8_BAR; PG8_MMA(1, 0, At, B0); PG8_MMA(1, 1, At, B1); PG8_BAR; PG8_SCHED;
            PG8_LDB(B0, 1, 0); PG8_LDB(B1, 1, 1); PG8_SCHED; PG8_LDA(At, 1, 0); PG8_STAGE(PG8_SA(0, 1), a2 + hsA, voffA);
            PG8_WAIT_V(8); PG8_WAIT_L(0); PG8_BAR; PG8_MMA(0, 0, At, B0); PG8_MMA(0, 1, At, B1); PG8_BAR; PG8_SCHED;
            PG8_LDA(At, 1, 1); PG8_STAGE(PG8_SB(1, 0), b3, voffB); PG8_STAGE(PG8_SB(1, 1), b3 + hsB, voffB); PG8_STAGE(PG8_SA(1, 0), a3, voffA);
            PG8_WAIT_V(8); PG8_WAIT_L(0); PG8_BAR; PG8_MMA(1, 0, At, B0); PG8_MMA(1, 1, At, B1); PG8_BAR; PG8_SCHED;
        }
        if (wr == 0) PG8_BAR;
        E(acc, cur, wr, wc, fr, fq);
        if (!has_next) break;
#pragma unroll
        for (int a = 0; a < 2; ++a)
#pragma unroll
            for (int b = 0; b < 2; ++b)
#pragma unroll
                for (int m = 0; m < 4; ++m)
#pragma unroll
                    for (int n = 0; n < 2; ++n) acc[a][b][m][n] = (f32x4){0.f, 0.f, 0.f, 0.f};
        cur = nxt; cA = nA; cB = nB; ++ui;
        if (wr == 1) PG8_BAR;
    }
    PG8_WAIT_V(0);
    PG8_BAR;
#undef PG8_RESOLVE
#undef PG8_SA
#undef PG8_SB
#undef PG8_STAGE
#undef PG8_LDA
#undef PG8_LDB
#undef PG8_MMA
#undef PG8_WAIT_V
#undef PG8_WAIT_L
#undef PG8_BAR
#undef PG8_SCHED
}
}

struct Args {
    const float* x; const int* pos; const float* norm1_g; const float* w_in; const float* mla_qg; const float* mla_wuq; const float* mla_kvg; const float* mla_wukv;
    const float* cmp_pe; const float* cmp_w; const float* fox_fb; const float* w_branch; const float* w_out; const float* norm2_g; const float* w_up; const float* w_down; const float* final_g;
    float* out; unsigned char* ws;
};

struct MapId { int off; __device__ int operator()(int n) const { return n + off; } };
struct MapZ { __device__ int operator()(int n) const {
    if (n < 1056) return n; if (n < 1824) return 1068 + (n - 1056); if (n < 2496) return 1840 + (n - 1824);
    if (n < 2508) return 1056 + (n - 2496); if (n < 2512) return 1836 + (n - 2508); if (n < 2520) return n; return -1; } };

template <class Map>
__device__ __forceinline__ void tr_item(const float* src, int sld, const Map map, bf16_t* dst, int dld, int drow0, int dcol0, LAS float* scr, int k0, int n0, int lane, const float* gk = nullptr) {
    const int sc = map(n0 + (lane & 31));
    float tv[32];
#pragma unroll
    for (int i = 0; i < 32; ++i) { const int kk = 2 * i + (lane >> 5); tv[i] = sc >= 0 ? src[(size_t)(k0 + kk) * sld + sc] : 0.f; }
    if (gk) {
#pragma unroll
        for (int i = 0; i < 32; ++i) tv[i] *= gk[k0 + 2 * i + (lane >> 5)]; }
#pragma unroll
    for (int i = 0; i < 32; ++i) { const int kk = 2 * i + (lane >> 5); scr[kk * 33 + (lane & 31)] = tv[i]; }
    LDS_WAIT(); asm volatile("" ::: "memory");
    const int c = lane & 7;
#pragma unroll
    for (int j = 0; j < 4; ++j) { const int n = (lane >> 3) + 8 * j; const LAS float* s = scr + (8 * c) * 33 + n;
        u32x4 o; o.x = pk2(s[0 * 33], s[1 * 33]); o.y = pk2(s[2 * 33], s[3 * 33]); o.z = pk2(s[4 * 33], s[5 * 33]); o.w = pk2(s[6 * 33], s[7 * 33]);
        *(u32x4*)(dst + (size_t)(drow0 + n0 + n) * dld + dcol0 + k0 + 8 * c) = o; }
    LDS_WAIT(); asm volatile("" ::: "memory");
}

template <class AT> __device__ __forceinline__ void p0_weights(const AT& a, int l, LAS unsigned char* lds, int gw, int NGW, int lane, int wave, int part) {
    LAS float* scr = (LAS float*)(lds + wave * 16384);
    unsigned char* ws = a.ws;
    constexpr int I0 = 16 * 80, I1 = 16 * 128, I2 = 4 * 12, I3 = 2 * 16, I5 = 2 * 32 * 2, I6 = 4 * 4 * 32, I7 = 16 * 32, I8 = 16 * 128, I9 = 64 * 32;
    constexpr int NIT = I0 + I1 + I2 + I3 + I5 + I6 + I7 + I8 + I9;
    constexpr int NA = I0 + I1 + I2 + I3 + I5 + I6 + I7;
    const int it_lo = (part == 1) ? NA : 0, it_hi = (part == 0) ? NA : NIT;
    for (int it = it_lo + gw; it < it_hi; it += NGW) {
        int r = it;
        if (r < I0) { tr_item(a.w_in + (size_t)l * DM * INC, INC, MapZ{}, (bf16_t*)(ws + WS_WZ), 1024, 0, 0, scr, (r / 80) * 64, (r % 80) * 32, lane, a.norm1_g + l * DM); continue; } r -= I0;
        if (r < I1) { tr_item(a.w_in + (size_t)l * DM * INC, INC, MapId{2520}, (bf16_t*)(ws + WS_WG), 1024, 0, 0, scr, (r / 128) * 64, (r % 128) * 32, lane, a.norm1_g + l * DM); continue; } r -= I1;
        if (r < I2) { tr_item(a.mla_wuq + (size_t)l * 256 * 384, 384, MapId{0}, (bf16_t*)(ws + WS_WMLA), 384, 0, 0, scr, (r / 12) * 64, (r % 12) * 32, lane); continue; } r -= I2;
        if (r < I3) { tr_item(a.mla_wukv + (size_t)l * 128 * 512, 512, MapId{0}, (bf16_t*)(ws + WS_WMLA), 384, 384, 256, scr, (r / 16) * 64, (r % 16) * 32, lane); continue; } r -= I3;
        if (r < I5) { const int kv = r / 64, q = r % 64; tr_item(a.cmp_w + ((size_t)l * 2 + kv) * 2048 * 64, 64, MapId{0}, (bf16_t*)(ws + WS_WCMP) + (size_t)kv * 256 * 2048, 2048, 0, 0, scr, (q / 2) * 64, (q % 2) * 32, lane); continue; } r -= I5;
        if (r < I6) { const int br = r / 128, q = r % 128; tr_item(a.w_branch + ((size_t)l * 4 + br) * 256 * 1024, 1024, MapId{0}, (bf16_t*)(ws + WS_WBR2) + (size_t)br * 1024 * 1024, 1024, 0, 0, scr, (q / 32) * 64, (q % 32) * 32, lane); continue; } r -= I6;
        if (r < I7) { tr_item(a.w_out + (size_t)l * DM * DM, 1024, MapId{0}, (bf16_t*)(ws + WS_WOUT4), 1024, 0, 0, scr, (r / 32) * 64, (r % 32) * 32, lane); continue; } r -= I7;
        if (r < I8) { tr_item(a.w_up + (size_t)l * DM * DFF, 4096, MapId{0}, (bf16_t*)(ws + WS_WUP), 1024, 0, 0, scr, (r / 128) * 64, (r % 128) * 32, lane, a.norm2_g + l * DM); continue; } r -= I8;
        tr_item(a.w_down + (size_t)l * DFF * DM, 1024, MapId{0}, (bf16_t*)(ws + WS_WDN), 4096, 0, 0, scr, (r / 32) * 64, (r % 32) * 32, lane);
    }
    if (part == 1) return;
    { bf16_t* W = (bf16_t*)(ws + WS_WMLA);
      for (int ch = gw * 64 + lane; ch < 1024 * 48; ch += NGW * 64) { const int row = ch / 48, col = (ch % 48) * 8;
          const bool keep = (row < 384 && col < 256) || (row >= 384 && row < 896 && col >= 256);
          if (!keep) { unsigned zz = 0u; asm volatile("" : "+v"(zz)); *(u32x4*)(W + (size_t)row * 384 + col) = (u32x4){zz, zz, zz, zz}; } } }
    { float* cb = (float*)(ws + WS_CMPB);
      for (int o = gw; o < 128; o += NGW) { const int kv = o >> 6, n = o & 63; const float* pe = a.cmp_pe + ((size_t)l * 2 + kv) * 2048; const float* w = a.cmp_w + ((size_t)l * 2 + kv) * 2048 * 64 + n;
          float s = 0.f; for (int j = lane; j < 2048; j += 64) s += pe[j] * w[(size_t)j * 64];
          s = wave_sum(s); if (lane == 0) cb[o] = s; } }
}

__device__ __forceinline__ void rms_row_bf16(const float* xrow, const float* g, bf16_t* orow, int lane) {
    const f32x4* xr = (const f32x4*)xrow + lane; const f32x4* gr = (const f32x4*)g + lane;
    f32x4 v[4]; float s = 0.f;
#pragma unroll
    for (int j = 0; j < 4; ++j) { v[j] = xr[64 * j]; s += (v[j].x * v[j].x + v[j].y * v[j].y) + (v[j].z * v[j].z + v[j].w * v[j].w); }
    const float rs = 1.0f / sqrtf(wave_sum(s) * (1.f / DM) + NORM_EPS);
    unsigned long long* o8 = (unsigned long long*)orow + lane;
#pragma unroll
    for (int j = 0; j < 4; ++j) { const f32x4 gg = gr[64 * j]; o8[64 * j] = (unsigned long long)pk2(v[j].x * rs * gg.x, v[j].y * rs * gg.y) | ((unsigned long long)pk2(v[j].z * rs * gg.z, v[j].w * rs * gg.w) << 32); }
}
__device__ __forceinline__ void rms_row_f32(float* xrow, const float* g, int lane) {
    f32x4* xr = (f32x4*)xrow + lane; const f32x4* gr = (const f32x4*)g + lane;
    f32x4 v[4]; float s = 0.f;
#pragma unroll
    for (int j = 0; j < 4; ++j) { v[j] = xr[64 * j]; s += (v[j].x * v[j].x + v[j].y * v[j].y) + (v[j].z * v[j].z + v[j].w * v[j].w); }
    const float rs = 1.0f / sqrtf(wave_sum(s) * (1.f / DM) + NORM_EPS);
#pragma unroll
    for (int j = 0; j < 4; ++j) { const f32x4 gg = gr[64 * j]; xr[64 * j] = (f32x4){v[j].x * rs * gg.x, v[j].y * rs * gg.y, v[j].z * rs * gg.z, v[j].w * rs * gg.w}; }
}

__device__ __forceinline__ void sincos_rr(float ang, float& s, float& c) {
    const float k = rintf(ang * 0.15915494309189535f);
    float r = fmaf(-k, 6.28125f, ang); r = fmaf(-k, 1.9353071795864769e-3f, r);
    s = __sinf(r); c = __cosf(r);
}
template <int NT, class AT> __device__ __forceinline__ void prep_tokens(const AT& a, int l, bf16_t* Zp, bf16_t* KCC, bf16_t* VCC, int tok0, int tstride, int lane) {
    bf16_t* z[NT]; float pos[NT];
#pragma unroll
    for (int k = 0; k < NT; ++k) { const int tok = tok0 + k * tstride; z[k] = Zp + (size_t)tok * ZW; pos[k] = (float)a.pos[tok]; }
    {
        u32x2 wq[NT]; unsigned wk[NT];
#pragma unroll
        for (int k = 0; k < NT; ++k) { wq[k] = *(const u32x2*)(z[k] + ZC_CQ + 4 * lane); wk[k] = *(const unsigned*)(z[k] + ZC_CKV + 2 * lane); }
        const f32x4 g = *(const f32x4*)(a.mla_qg + l * 256 + 4 * lane);
        const float g0 = a.mla_kvg[l * 128 + 2 * lane], g1 = a.mla_kvg[l * 128 + 2 * lane + 1];
#pragma unroll
        for (int k = 0; k < NT; ++k) {
            const float v0 = bflo(wq[k].x), v1 = bfhi(wq[k].x), v2 = bflo(wq[k].y), v3 = bfhi(wq[k].y);
            const float rs = 1.0f / sqrtf(wave_sum(v0 * v0 + v1 * v1 + v2 * v2 + v3 * v3) * (1.f / 256.f) + NORM_EPS);
            u32x2 o; o.x = pk2(v0 * rs * g.x, v1 * rs * g.y); o.y = pk2(v2 * rs * g.z, v3 * rs * g.w); *(u32x2*)(z[k] + ZC_CQ + 4 * lane) = o;
            const float u0 = bflo(wk[k]), u1 = bfhi(wk[k]);
            const float rk = 1.0f / sqrtf(wave_sum(u0 * u0 + u1 * u1) * (1.f / 128.f) + NORM_EPS);
            *(unsigned*)(z[k] + ZC_CKV + 2 * lane) = pk2(u0 * rk * g0, u1 * rk * g1);
        }
    }
#pragma unroll
    for (int it = 0; it < 3; ++it) {
        const int p = lane + 64 * it;
        if (p < 148) {
            int col, half, j; float rot;
            if (p < 16) { col = ZC_KR; half = 16; j = p; rot = 32.f; }
            else if (p < 112) { const int v = (p - 16) >> 3; j = (p - 16) & 7; half = 8; rot = 16.f;
                col = v < 4 ? ZC_NQ + 64 * v : v == 4 ? ZC_NKC : v == 5 ? ZC_NKS : v == 6 ? ZC_NKW : v < 11 ? ZC_DQ + 64 * (v - 7) : ZC_DK; }
            else { const int v = (p - 112) >> 2; j = (p - 112) & 3; half = 4; rot = 8.f; col = v < 8 ? ZC_DQI + 32 * v : ZC_DKI; }
            const float inv = exp2f(-((float)(2 * j) / rot) * 18.931568569324174f);
            float x1[NT], x2[NT];
#pragma unroll
            for (int k = 0; k < NT; ++k) { x1[k] = bf2f(z[k][col + j]); x2[k] = bf2f(z[k][col + half + j]); }
#pragma unroll
            for (int k = 0; k < NT; ++k) {
                float sn, cs; sincos_rr(pos[k] * inv, sn, cs);
                const unsigned y1 = f2bf(x1[k] * cs - x2[k] * sn), y2 = f2bf(x2[k] * cs + x1[k] * sn);
                z[k][col + j] = (bf16_t)y1; z[k][col + half + j] = (bf16_t)y2;
                if (col == ZC_NKC) { const size_t tb = (size_t)(tok0 + k * tstride) * 64; KCC[tb + j] = (bf16_t)y1; KCC[tb + 8 + j] = (bf16_t)y2; }
            }
        }
    }
    unsigned cp[NT];
#pragma unroll
    for (int k = 0; k < NT; ++k) cp[k] = (lane < 24) ? *(const unsigned*)(z[k] + ZC_NKC + 16 + 2 * lane) : (lane >= 32 ? *(const unsigned*)(z[k] + ZC_NVC + 2 * (lane - 32)) : 0u);
#pragma unroll
    for (int k = 0; k < NT; ++k) { const size_t tb = (size_t)(tok0 + k * tstride) * 64;
        if (lane < 24) *(unsigned*)(KCC + tb + 16 + 2 * lane) = cp[k];
        if (lane >= 32) *(unsigned*)(VCC + tb + 2 * (lane - 32)) = cp[k]; }
}
template <class AT> __device__ __forceinline__ void fox_scan(const AT& a, int l, const bf16_t* Z, float* FC, int bh, int lane) {
    const int b = bh >> 2, h = bh & 3; const float fb = a.fox_fb[l * 4 + h];
    float v[32]; float tot = 0.f;
#pragma unroll
    for (int i = 0; i < 32; ++i) { const int t = lane * 32 + i; const float x = bf2f(Z[(size_t)(b * SEQ + t) * ZW + ZC_FF + h]) + fb;
        const float ls = fminf(x, 0.f) - logf(1.f + expf(-fabsf(x))); tot += ls; v[i] = tot; }
    float incl = tot;
#pragma unroll
    for (int o = 1; o < 64; o <<= 1) { const float n = __shfl_up(incl, o); if (lane >= o) incl += n; }
    const float excl = incl - tot;
#pragma unroll
    for (int i = 0; i < 32; ++i) FC[(size_t)(b * SEQ + lane * 32 + i) * 4 + h] = excl + v[i];
}

namespace att {
constexpr int VROW = 144;
constexpr int OFF_K = 0, OFF_V = 2 * 64 * 208, OFF_KB = OFF_V + 2 * 64 * VROW, OFF_MISC = OFF_KB + 2 * 64 * 4;
__device__ __forceinline__ int kslot(int k) { return (k & 32) + (k & 3) + 4 * ((k >> 4) & 1) + 8 * ((k >> 2) & 3); }

template <int DK, class P> struct Stage {
    static constexpr int KROW = DK * 2 + 16, CPR = DK / 8, NCH = (64 * CPR + 511) / 512;
    u32x4 kreg[NCH]; u32x4 v0, v1; float kb;
    __device__ __forceinline__ void load(const P& pol, int kt, int tid) {
#pragma unroll
        for (int i = 0; i < NCH; ++i) { const int id = tid + i * 512; if (id < 64 * CPR) { const int key = id / CPR, ch = id % CPR; kreg[i] = *(const u32x4*)pol.kptr(kt * 64 + key, ch); } }
        if (tid < 256) { const int p = tid & 31, dch = tid >> 5; v0 = *(const u32x4*)pol.vptr(kt * 64 + 2 * p, dch); v1 = *(const u32x4*)pol.vptr(kt * 64 + 2 * p + 1, dch); }
        if constexpr (P::HAS_KBIAS) { if (tid >= 256 && tid < 320) kb = pol.kbias(kt * 64 + tid - 256); }
    }
    __device__ __forceinline__ void store(LAS unsigned char* lds, int buf, int tid) {
#pragma unroll
        for (int i = 0; i < NCH; ++i) { const int id = tid + i * 512; if (id < 64 * CPR) { const int key = id / CPR, ch = id % CPR;
            *(LAS u32x4*)(lds + OFF_K + buf * 64 * KROW + kslot(key) * KROW + ch * 16) = kreg[i]; } }
        if (tid < 256) { const int p = tid & 31, dch = tid >> 5; LAS unsigned char* vb = lds + OFF_V + buf * 64 * VROW + (8 * dch) * VROW + p * 4;
#pragma unroll
            for (int j = 0; j < 4; ++j) { *(LAS unsigned*)(vb + (2 * j) * VROW) = (v0[j] & 0xffffu) | (v1[j] << 16); *(LAS unsigned*)(vb + (2 * j + 1) * VROW) = (v0[j] >> 16) | (v1[j] & 0xffff0000u); } }
        if (P::HAS_KBIAS) { if (tid >= 256 && tid < 320) *(LAS float*)(lds + OFF_KB + buf * 256 + (tid - 256) * 4) = kb; }
    }
};


template <int DK> __device__ __forceinline__ void qk_scores(LAS unsigned char* lds, int buf, const bf16x8 (&qf)[DK / 16], int r32, int hi, f32x16& s0, f32x16& s1) {
    constexpr int KROW = DK * 2 + 16;
#pragma unroll
    for (int r = 0; r < 16; ++r) { s0[r] = 0.f; s1[r] = 0.f; }
    const LAS unsigned char* kb0 = lds + OFF_K + buf * 64 * KROW + r32 * KROW + hi * 16;
#pragma unroll
    for (int stp = 0; stp < DK / 16; ++stp) {
        const bf16x8 k0 = *(const LAS bf16x8*)(kb0 + stp * 32), k1 = *(const LAS bf16x8*)(kb0 + 32 * KROW + stp * 32);
        s0 = __builtin_amdgcn_mfma_f32_32x32x16_bf16(k0, qf[stp], s0, 0, 0, 0);
        s1 = __builtin_amdgcn_mfma_f32_32x32x16_bf16(k1, qf[stp], s1, 0, 0, 0);
    }
}
__device__ __forceinline__ void pv_acc(LAS unsigned char* lds, int buf, int r32, int hi, const f32x16& s0, const f32x16& s1, f32x16 (&o)[2]) {
    const LAS unsigned char* vb0 = lds + OFF_V + buf * 64 * VROW + r32 * VROW + hi * 32;
#pragma unroll
    for (int half = 0; half < 2; ++half)
#pragma unroll
        for (int j = 0; j < 2; ++j) {
            const f32x16& s = half ? s1 : s0;
            u32x4 pw; pw.x = cvt_pk_bf16(s[8 * j + 0], s[8 * j + 1]); pw.y = cvt_pk_bf16(s[8 * j + 2], s[8 * j + 3]); pw.z = cvt_pk_bf16(s[8 * j + 4], s[8 * j + 5]); pw.w = cvt_pk_bf16(s[8 * j + 6], s[8 * j + 7]);
            const bf16x8 pb = __builtin_bit_cast(bf16x8, pw);
            const bf16x8 va = *(const LAS bf16x8*)(vb0 + half * 64 + j * 16), vc = *(const LAS bf16x8*)(vb0 + 32 * VROW + half * 64 + j * 16);
            o[0] = __builtin_amdgcn_mfma_f32_32x32x16_bf16(va, pb, o[0], 0, 0, 0);
            o[1] = __builtin_amdgcn_mfma_f32_32x32x16_bf16(vc, pb, o[1], 0, 0, 0);
        }
}
template <int DK, class P>
__device__ __forceinline__ void flash_run(LAS unsigned char* lds, P& pol, unsigned tmask, const bf16x8 (&qf)[DK / 16], float& m_run, float& l_run, f32x16 (&o)[2], int tid) {
    const int lane = tid & 63, r32 = lane & 31, hi = lane >> 5;
    if (tmask == 0u) return;
    Stage<DK, P> st;
    int kt = __builtin_ctz(tmask); tmask &= tmask - 1;
    __syncthreads();
    st.load(pol, kt, tid); st.store(lds, 0, tid);
    __syncthreads();
    int buf = 0;
    for (;;) {
        const int ktn = tmask ? __builtin_ctz(tmask) : -1; if (tmask) tmask &= tmask - 1;
        if (ktn >= 0) st.load(pol, ktn, tid);
        if (!pol.wave_skip(kt)) {
            pol.prep(kt);
            f32x16 s0, s1;
            qk_scores<DK>(lds, buf, qf, r32, hi, s0, s1);
            float mx = NEGF;
            const bool full = pol.full(kt);
            if constexpr (P::HAS_KBIAS) {
                const LAS float* kbl = (const LAS float*)(lds + OFF_KB + buf * 256) + 16 * hi;
#pragma unroll
                for (int r = 0; r < 16; ++r) { s0[r] = fmaf(s0[r], pol.c2, pol.qbias - kbl[r]); s1[r] = fmaf(s1[r], pol.c2, pol.qbias - kbl[32 + r]); }
            }
            if (!full) {
#pragma unroll
                for (int r = 0; r < 16; ++r) { s0[r] = pol.valid(kt, 0, r) ? s0[r] : NEGF; s1[r] = pol.valid(kt, 1, r) ? s1[r] : NEGF; }
            }
            { float ma = s0[0], mb = s1[0], mc = s0[1], md = s1[1];
#pragma unroll
              for (int r = 2; r < 16; r += 2) { ma = fmax1(ma, s0[r]); mb = fmax1(mb, s1[r]); mc = fmax1(mc, s0[r + 1]); md = fmax1(md, s1[r + 1]); }
              mx = fmax1(fmax1(ma, mb), fmax1(mc, md)); }
            mx = fmax1(mx, xchg32(mx));
            float ls = 0.f; float m_new;
            if constexpr (P::HAS_KBIAS) {
                m_new = fmaxf(m_run, mx);
#pragma unroll
                for (int r = 0; r < 16; ++r) { s0[r] = __builtin_amdgcn_exp2f(s0[r] - m_new); s1[r] = __builtin_amdgcn_exp2f(s1[r] - m_new); ls += s0[r] + s1[r]; }
            } else {
                m_new = fmaxf(m_run, mx * pol.c2);
#pragma unroll
                for (int r = 0; r < 16; ++r) { s0[r] = __builtin_amdgcn_exp2f(fmaf(s0[r], pol.c2, -m_new)); s1[r] = __builtin_amdgcn_exp2f(fmaf(s1[r], pol.c2, -m_new)); ls += s0[r] + s1[r]; }
            }
            const float alpha = __builtin_amdgcn_exp2f(m_run - m_new);
            l_run = l_run * alpha + ls; m_run = m_new;
            if (__ballot(alpha != 1.f) != 0ull) {
#pragma unroll
                for (int r = 0; r < 16; ++r) { o[0][r] *= alpha; o[1][r] *= alpha; }
            }
            pv_acc(lds, buf, r32, hi, s0, s1, o);
        }
        if (ktn < 0) break;
        st.store(lds, buf ^ 1, tid);
        __syncthreads();
        buf ^= 1; kt = ktn;
    }
}
__device__ __forceinline__ void store_o(bf16_t* orow, const f32x16 (&o)[2], float w, int hi) {
#pragma unroll
    for (int dacc = 0; dacc < 2; ++dacc)
#pragma unroll
        for (int g = 0; g < 4; ++g) { u32x2 v; v.x = cvt_pk_bf16(o[dacc][4 * g] * w, o[dacc][4 * g + 1] * w); v.y = cvt_pk_bf16(o[dacc][4 * g + 2] * w, o[dacc][4 * g + 3] * w);
            *(u32x2*)(orow + dacc * 32 + 8 * g + 4 * hi) = v; }
}

struct PolFox {
    static constexpr bool HAS_KBIAS = true;
    const bf16_t* zb; const float* fc; int h; int t; int hi; int wlast; float c2, qbias;
    __device__ __forceinline__ const bf16_t* kptr(int key, int ch) const { return zb + (size_t)key * ZW + ZC_FK + h * 64 + ch * 8; }
    __device__ __forceinline__ const bf16_t* vptr(int key, int dch) const { return zb + (size_t)key * ZW + ZC_FV + h * 64 + dch * 8; }
    __device__ __forceinline__ float kbias(int key) const { return fc[(size_t)key * 4 + h] * LOG2E; }
    __device__ __forceinline__ bool wave_skip(int kt) const { return kt * 64 > wlast; }
    __device__ __forceinline__ bool full(int kt) const { return kt * 64 + 63 <= wlast - 31; }
    __device__ __forceinline__ void prep(int) {}
    __device__ __forceinline__ bool valid(int kt, int half, int r) const { return kt * 64 + 32 * half + 16 * hi + r <= t; }
};
__device__ __forceinline__ void fox_unit(LAS unsigned char* lds, const bf16_t* Z, const float* FC, bf16_t* O, int b, int h, int qb, int tid) {
    const int lane = tid & 63, r32 = lane & 31, hi = lane >> 5, wave = tid >> 6;
    const int t = qb * 256 + wave * 32 + r32;
    PolFox pol; pol.zb = Z + (size_t)b * SEQ * ZW; pol.fc = FC + (size_t)b * SEQ * 4; pol.h = h; pol.t = t; pol.hi = hi; pol.wlast = qb * 256 + wave * 32 + 31; pol.c2 = 0.125f * LOG2E;
    pol.qbias = pol.fc[(size_t)t * 4 + h] * LOG2E;
    bf16x8 qf[4];
    const bf16_t* qrow = pol.zb + (size_t)t * ZW + ZC_FQ + h * 64;
#pragma unroll
    for (int s = 0; s < 4; ++s) qf[s] = *(const bf16x8*)(qrow + s * 16 + 8 * hi);
    float m_run = -1e20f, l_run = 0.f; f32x16 o[2];
#pragma unroll
    for (int r = 0; r < 16; ++r) { o[0][r] = 0.f; o[1][r] = 0.f; }
    const unsigned tmask = (qb == 7) ? 0xffffffffu : ((1u << (4 * qb + 4)) - 1u);
    flash_run<64, PolFox>(lds, pol, tmask, qf, m_run, l_run, o, tid);
    const float lt = l_run + xchg32(l_run);
    store_o(O + (size_t)(b * SEQ + t) * DM + 512 + h * 64, o, lt > 0.f ? 1.f / lt : 0.f, hi);
}

struct PolMla {
    static constexpr bool HAS_KBIAS = false;
    const bf16_t* qb_; const bf16_t* zb; int h; int t; int hi; int wlast; float c2;
    __device__ __forceinline__ const bf16_t* kptr(int key, int ch) const { return ch < 8 ? qb_ + (size_t)key * 1024 + 384 + h * 128 + ch * 8 : zb + (size_t)key * ZW + ZC_KR + (ch - 8) * 8; }
    __device__ __forceinline__ const bf16_t* vptr(int key, int dch) const { return qb_ + (size_t)key * 1024 + 384 + h * 128 + 64 + dch * 8; }
    __device__ __forceinline__ bool wave_skip(int kt) const { return kt * 64 > wlast; }
    __device__ __forceinline__ bool full(int kt) const { return kt * 64 + 63 <= wlast - 31; }
    __device__ __forceinline__ void prep(int) {}
    __device__ __forceinline__ bool valid(int kt, int half, int r) const { return kt * 64 + 32 * half + 16 * hi + r <= t; }
};
__device__ __forceinline__ void mla_unit(LAS unsigned char* lds, const bf16_t* QKVM, const bf16_t* Z, const int* posp, bf16_t* O, int b, int h, int qb, int tid) {
    const int lane = tid & 63, r32 = lane & 31, hi = lane >> 5, wave = tid >> 6;
    const int t = qb * 256 + wave * 32 + r32;
    PolMla pol; pol.qb_ = QKVM + (size_t)b * SEQ * 1024; pol.zb = Z + (size_t)b * SEQ * ZW; pol.h = h; pol.t = t; pol.hi = hi; pol.wlast = qb * 256 + wave * 32 + 31;
    pol.c2 = 0.10206207261596577f * LOG2E;
    bf16x8 qf[6];
    const bf16_t* qrow = pol.qb_ + (size_t)t * 1024 + h * 96;
#pragma unroll
    for (int s = 0; s < 6; ++s) qf[s] = *(const bf16x8*)(qrow + s * 16 + 8 * hi);
    {
        const float pos = (float)posp[b * SEQ + t];
        u32x4 a4 = __builtin_bit_cast(u32x4, qf[4]), b4 = __builtin_bit_cast(u32x4, qf[5]);
        float x1[8], x2[8];
#pragma unroll
        for (int i = 0; i < 4; ++i) { x1[2 * i] = bflo(a4[i]); x1[2 * i + 1] = bfhi(a4[i]); x2[2 * i] = bflo(b4[i]); x2[2 * i + 1] = bfhi(b4[i]); }
#pragma unroll
        for (int i = 0; i < 8; ++i) { const int j = 8 * hi + i; const float inv = __builtin_amdgcn_exp2f(-((float)(2 * j) / 32.f) * 18.931568569324174f);
            float sn, cs; sincos_rr(pos * inv, sn, cs); const float y1 = x1[i] * cs - x2[i] * sn, y2 = x2[i] * cs + x1[i] * sn; x1[i] = y1; x2[i] = y2; }
#pragma unroll
        for (int i = 0; i < 4; ++i) { a4[i] = cvt_pk_bf16(x1[2 * i], x1[2 * i + 1]); b4[i] = cvt_pk_bf16(x2[2 * i], x2[2 * i + 1]); }
        qf[4] = __builtin_bit_cast(bf16x8, a4); qf[5] = __builtin_bit_cast(bf16x8, b4);
    }
    float m_run = -1e20f, l_run = 0.f; f32x16 o[2];
#pragma unroll
    for (int r = 0; r < 16; ++r) { o[0][r] = 0.f; o[1][r] = 0.f; }
    const unsigned tmask = (qb == 7) ? 0xffffffffu : ((1u << (4 * qb + 4)) - 1u);
    flash_run<96, PolMla>(lds, pol, tmask, qf, m_run, l_run, o, tid);
    const float lt = l_run + xchg32(l_run);
    store_o(O + (size_t)(b * SEQ + t) * DM + 0 + h * 64, o, lt > 0.f ? 1.f / lt : 0.f, hi);
}

struct PolDsa {
    static constexpr bool HAS_KBIAS = false;
    const bf16_t* zb; const unsigned long long* selrow; int hi; int wlast; float c2; unsigned m0, m1;
    __device__ __forceinline__ const bf16_t* kptr(int key, int ch) const { return zb + (size_t)key * ZW + ZC_DK + ch * 8; }
    __device__ __forceinline__ const bf16_t* vptr(int key, int dch) const { return zb + (size_t)key * ZW + ZC_DV + dch * 8; }
    __device__ __forceinline__ bool wave_skip(int kt) const { return kt * 64 > wlast; }
    __device__ __forceinline__ bool full(int) const { return false; }
    __device__ __forceinline__ void prep(int kt) { const unsigned long long w = selrow[kt]; m0 = (unsigned)(w >> (16 * hi)); m1 = (unsigned)(w >> (32 + 16 * hi)); }
    __device__ __forceinline__ bool valid(int kt, int half, int r) const { return (((half ? m1 : m0) >> r) & 1u) != 0u; }
};
__device__ __forceinline__ void dsa_unit(LAS unsigned char* lds, const bf16_t* Z, const unsigned long long* SELM, bf16_t* O, int b, int tq, int tid) {
    const int lane = tid & 63, r32 = lane & 31, hi = lane >> 5, wave = tid >> 6, h = wave >> 1;
    const int t = tq * 64 + (wave & 1) * 32 + r32;
    PolDsa pol; pol.zb = Z + (size_t)b * SEQ * ZW; pol.selrow = SELM + (size_t)(b * SEQ + t) * 32; pol.hi = hi; pol.wlast = tq * 64 + (wave & 1) * 32 + 31; pol.c2 = 0.125f * LOG2E; pol.m0 = 0; pol.m1 = 0;
    bf16x8 qf[4];
    const bf16_t* qrow = pol.zb + (size_t)t * ZW + ZC_DQ + h * 64;
#pragma unroll
    for (int s = 0; s < 4; ++s) qf[s] = *(const bf16x8*)(qrow + s * 16 + 8 * hi);
    float m_run = -1e20f, l_run = 0.f; f32x16 o[2];
#pragma unroll
    for (int r = 0; r < 16; ++r) { o[0][r] = 0.f; o[1][r] = 0.f; }
    const unsigned tmask = (tq == 31) ? 0xffffffffu : ((1u << (tq + 1)) - 1u);
    flash_run<64, PolDsa>(lds, pol, tmask, qf, m_run, l_run, o, tid);
    const float lt = l_run + xchg32(l_run);
    store_o(O + (size_t)(b * SEQ + t) * DM + 768 + h * 64, o, lt > 0.f ? 1.f / lt : 0.f, hi);
}

__device__ __forceinline__ void dsa_index_unit(LAS unsigned char* lds, const bf16_t* Z, unsigned long long* SELM, int b, int tq16, int tid) {
    const int lane = tid & 63, r32 = lane & 31, hi = lane >> 5, wave = __builtin_amdgcn_readfirstlane(tid >> 6);
    const int t0 = tq16 * 16, ntile = (t0 + 16 + 31) >> 5;
    const bf16_t* zb = Z + (size_t)b * SEQ * ZW;
    LAS float* sc = (LAS float*)lds;
    __syncthreads();
    {
        const int mt = wave & 3, kpar = wave >> 2;
        const int ql_a = r32 >> 3, hh_a = r32 & 7;
        const bf16_t* qirow = zb + (size_t)(t0 + 4 * mt + ql_a) * ZW + ZC_DQI + hh_a * 32 + 8 * hi;
        const bf16x8 a0 = *(const bf16x8*)(qirow), a1 = *(const bf16x8*)(qirow + 16);
        float wv[4][4];
#pragma unroll
        for (int ql = 0; ql < 4; ++ql) { const u32x2 w = *(const u32x2*)(zb + (size_t)(t0 + 4 * mt + ql) * ZW + ZC_DW + 4 * hi);
            wv[ql][0] = bflo(w.x) * 0.0625f; wv[ql][1] = bfhi(w.x) * 0.0625f; wv[ql][2] = bflo(w.y) * 0.0625f; wv[ql][3] = bfhi(w.y) * 0.0625f; }
        bf16x8 xa0[4], xa1[4], xb0[4], xb1[4];
        auto ldb = [&](int tile0, bf16x8 (&b0)[4], bf16x8 (&b1)[4]) {
#pragma unroll
            for (int i2 = 0; i2 < 4; ++i2) { const int tile = tile0 + 2 * i2; const int key = (tile < ntile ? tile : kpar) * 32 + r32;
                const bf16_t* kirow = zb + (size_t)key * ZW + ZC_DKI + 8 * hi; b0[i2] = *(const bf16x8*)(kirow); b1[i2] = *(const bf16x8*)(kirow + 16); }
        };
        auto score = [&](int tile0, const bf16x8 (&b0)[4], const bf16x8 (&b1)[4]) {
#pragma unroll
            for (int i2 = 0; i2 < 4; ++i2) { const int tile = tile0 + 2 * i2; if (tile < ntile) {
                const int key = tile * 32 + r32;
                f32x16 sv;
#pragma unroll
                for (int r = 0; r < 16; ++r) sv[r] = 0.f;
                sv = __builtin_amdgcn_mfma_f32_32x32x16_bf16(a0, b0[i2], sv, 0, 0, 0);
                sv = __builtin_amdgcn_mfma_f32_32x32x16_bf16(a1, b1[i2], sv, 0, 0, 0);
                float p0 = 0.f, p1 = 0.f, p2 = 0.f, p3 = 0.f;
#pragma unroll
                for (int e = 0; e < 4; ++e) { p0 += fmax1(sv[e], 0.f) * wv[0][e]; p1 += fmax1(sv[4 + e], 0.f) * wv[1][e]; p2 += fmax1(sv[8 + e], 0.f) * wv[2][e]; p3 += fmax1(sv[12 + e], 0.f) * wv[3][e]; }
                p0 += xchg32(p0); p1 += xchg32(p1); p2 += xchg32(p2); p3 += xchg32(p3);
                const float va = hi ? p2 : p0, vb = hi ? p3 : p1;
                const int qa = 4 * mt + 2 * hi;
                sc[qa * 2048 + key] = (key <= t0 + qa) ? va : NEGF;
                sc[(qa + 1) * 2048 + key] = (key <= t0 + qa + 1) ? vb : NEGF; } }
        };
        int tile0 = kpar;
        if (tile0 < ntile) ldb(tile0, xa0, xa1);
        while (tile0 < ntile) {
            if (tile0 + 8 < ntile) ldb(tile0 + 8, xb0, xb1);
            score(tile0, xa0, xa1);
            tile0 += 8; if (tile0 >= ntile) break;
            if (tile0 + 8 < ntile) ldb(tile0 + 8, xa0, xa1);
            score(tile0, xb0, xb1);
            tile0 += 8;
        }
    }
    __syncthreads();
#pragma unroll 1
    for (int rr = 0; rr < 2; ++rr) {
        const int q = wave * 2 + rr, t = t0 + q;
        unsigned long long mine = 0ull;
        if (t + 1 <= 256) {
#pragma unroll
            for (int j = 0; j < 32; ++j) { const unsigned long long bal = __ballot(j * 64 + lane <= t); if (lane == j) mine = bal; }
        } else {
            unsigned u[32];
#pragma unroll
            for (int j = 0; j < 32; ++j) { const int key = j * 64 + lane; unsigned bits = 0u;
                if (key <= t) { const unsigned fb = __float_as_uint(sc[q * 2048 + key]); bits = (fb & 0x80000000u) ? ~fb : (fb | 0x80000000u); }
                u[j] = bits; }
            int cpos = 0;
#pragma unroll
            for (int j = 0; j < 32; ++j) cpos += (u[j] >= 0x80000000u) ? 1 : 0;
            cpos = (int)wred_add((unsigned)cpos);
            const bool pcls = cpos >= 256;
            unsigned umax = 0u, umin = 0xffffffffu;
#pragma unroll
            for (int j = 0; j < 32; ++j) { const bool in = pcls ? (u[j] >= 0x80000000u) : (u[j] < 0x80000000u && u[j] != 0u);
                const unsigned vmx = in ? u[j] : 0u, vmn = in ? u[j] : 0xffffffffu; umax = vmx > umax ? vmx : umax; umin = vmn < umin ? vmn : umin; }
            umax = wred_umax(umax); umin = ~wred_umax(~umin);
            const unsigned xr = umax ^ umin;
            int bw = xr ? 32 - __builtin_clz(xr) : 0;
            unsigned T = (umax >> bw) << bw;
            int cntT = pcls ? cpos : t + 1, cntHi = pcls ? 0 : cpos;
            bool compact = false; unsigned uc = 0u; int aboveC = 0;
            LAS unsigned* cbuf = (LAS unsigned*)(lds + 131072 + 1024) + wave * 64;
#pragma unroll 1
            while (bw > 0) {
                if (!compact && bw < 32 && cntT - cntHi <= 64) {
                    int base = 0; const unsigned long long ltm = (lane == 0) ? 0ull : (~0ull >> (64 - lane));
#pragma unroll
                    for (int j = 0; j < 32; ++j) { const bool act = (u[j] - T) < (1u << bw) && u[j] >= T && u[j] != 0u; const unsigned long long bal = __ballot(act);
                        if (act) cbuf[base + __builtin_popcountll(bal & ltm)] = u[j]; base += __builtin_popcountll(bal); }
                    LDS_WAIT();
                    uc = (lane < base) ? cbuf[lane] : 0u;
                    LDS_WAIT();
                    compact = true; aboveC = cntHi;
                }
                --bw;
                const unsigned cand = T + (1u << bw); int c;
                if (compact) c = aboveC + __builtin_popcountll(__ballot(uc >= cand));
                else { c = 0;
#pragma unroll
                    for (int j = 0; j < 32; ++j) c += (u[j] >= cand) ? 1 : 0;
                    c = (int)wred_add((unsigned)c); }
                if (c >= 256) { T = cand; cntT = c; } else cntHi = c;
            }
            if (cntT == 256) {
#pragma unroll
                for (int j = 0; j < 32; ++j) { const unsigned long long bal = __ballot(u[j] >= T); if (lane == j) mine = bal; }
            } else {
                int need = 256 - cntHi;
                const unsigned long long lt_mask = (lane == 0) ? 0ull : (~0ull >> (64 - lane));
#pragma unroll
                for (int j = 0; j < 32; ++j) { const unsigned long long gt = __ballot(u[j] > T), eq = __ballot(u[j] == T);
                    const int rank = __builtin_popcountll(eq & lt_mask);
                    const unsigned long long take = __ballot(u[j] == T && rank < need);
                    need -= __builtin_popcountll(take); if (need < 0) need = 0;
                    const unsigned long long bal = gt | take; if (lane == j) mine = bal; }
            }
        }
        if (lane < 32) SELM[(size_t)(b * SEQ + t) * 32 + lane] = mine;
    }
}

constexpr int OFF_IMPA = OFF_MISC, IMP_BYTES = 4 * 64 * 33 * 4, OFF_IMPB = OFF_IMPA + IMP_BYTES, OFF_SELQ = OFF_IMPB + IMP_BYTES, OFF_SELU = OFF_SELQ + 256;
struct PolCmp {
    static constexpr bool HAS_KBIAS = false;
    const bf16_t* kc; const bf16_t* vc;
    __device__ __forceinline__ const bf16_t* kptr(int key, int ch) const { return kc + (size_t)key * 64 + ch * 8; }
    __device__ __forceinline__ const bf16_t* vptr(int key, int dch) const { return vc + (size_t)key * 64 + dch * 8; }
};
struct PolSel {
    static constexpr bool HAS_KBIAS = false;
    const bf16_t* zb; int t; int hi; unsigned selq; float c2;
    __device__ __forceinline__ const bf16_t* kptr(int key, int ch) const { return zb + (size_t)key * ZW + ZC_NKS + ch * 8; }
    __device__ __forceinline__ const bf16_t* vptr(int key, int dch) const { return zb + (size_t)key * ZW + ZC_NVS + dch * 8; }
    __device__ __forceinline__ bool wave_skip(int kt) const { return __ballot((selq >> kt) & 1u) == 0ull; }
    __device__ __forceinline__ bool full(int) const { return false; }
    __device__ __forceinline__ void prep(int) {}
    __device__ __forceinline__ bool valid(int kt, int half, int r) const { return ((selq >> kt) & 1u) && (kt * 64 + 32 * half + 16 * hi + r <= t); }
};
struct PolWin {
    static constexpr bool HAS_KBIAS = false;
    const bf16_t* zb; int t; int hi; int w0; float c2;
    __device__ __forceinline__ const bf16_t* kptr(int key, int ch) const { return zb + (size_t)key * ZW + ZC_NKW + ch * 8; }
    __device__ __forceinline__ const bf16_t* vptr(int key, int dch) const { return zb + (size_t)key * ZW + ZC_NVW + dch * 8; }
    __device__ __forceinline__ bool wave_skip(int kt) const { return (kt * 64 > w0 + 31) || (kt * 64 + 63 <= w0 - 512); }
    __device__ __forceinline__ bool full(int kt) const { return (kt * 64 + 63 <= w0) && (kt * 64 > w0 + 31 - 512); }
    __device__ __forceinline__ void prep(int) {}
    __device__ __forceinline__ bool valid(int kt, int half, int r) const { const int key = kt * 64 + 32 * half + 16 * hi + r; return key <= t && key > t - 512; }
};
__device__ __forceinline__ void nsa_unit(LAS unsigned char* lds, const bf16_t* Z, const bf16_t* KCMP, const bf16_t* VCMP, bf16_t* O, int b, int tq, int tid) {
    const int lane = tid & 63, r32 = lane & 31, hi = lane >> 5, wave = tid >> 6, h = wave >> 1;
    const int ql = (wave & 1) * 32 + r32, t = tq * 64 + ql;
    const bf16_t* zb = Z + (size_t)b * SEQ * ZW;
    const float c2 = 0.125f * LOG2E;
    bf16x8 qf[4];
    const bf16_t* qrow = zb + (size_t)t * ZW + ZC_NQ + h * 64;
#pragma unroll
    for (int s = 0; s < 4; ++s) qf[s] = *(const bf16x8*)(qrow + s * 16 + 8 * hi);
    float g0, g1, g2;
    { const bf16_t* gp = zb + (size_t)t * ZW + ZC_NG; g0 = 1.f / (1.f + __expf(-bf2f(gp[h]))); g1 = 1.f / (1.f + __expf(-bf2f(gp[4 + h]))); g2 = 1.f / (1.f + __expf(-bf2f(gp[8 + h]))); }
    f32x16 ot[2];
#pragma unroll
    for (int r = 0; r < 16; ++r) { ot[0][r] = 0.f; ot[1][r] = 0.f; }
    LAS float* impA = (LAS float*)(lds + OFF_IMPA); LAS float* impB = (LAS float*)(lds + OFF_IMPB);
    LAS unsigned* selq_l = (LAS unsigned*)(lds + OFF_SELQ); LAS unsigned* selu_l = (LAS unsigned*)(lds + OFF_SELU);
    {
        PolCmp pc; pc.kc = KCMP + (size_t)b * 128 * 64; pc.vc = VCMP + (size_t)b * 128 * 64;
        {
            Stage<64, PolCmp> st;
            __syncthreads();
            st.load(pc, 0, tid); st.store(lds, 0, tid);
            st.load(pc, 1, tid); st.store(lds, 1, tid);
            if (tid < 64) { selu_l[0] = 0u; selq_l[tid] = 0u; }
            __syncthreads();
        }
        float mx = NEGF;
#pragma unroll 1
        for (int kt = 0; kt < 2; ++kt) {
            f32x16 s0, s1;
            qk_scores<64>(lds, kt, qf, r32, hi, s0, s1);
#pragma unroll
            for (int r = 0; r < 16; ++r) { const int c0 = 64 * kt + 16 * hi + r, c1 = c0 + 32;
                if ((c0 * 16 + 31 <= t) && (c0 < 127)) mx = fmaxf(mx, s0[r] * c2);
                if ((c1 * 16 + 31 <= t) && (c1 < 127)) mx = fmaxf(mx, s1[r] * c2); }
        }
        mx = fmaxf(mx, xchg32(mx));
        float ls = 0.f;
        f32x16 oc[2];
#pragma unroll
        for (int r = 0; r < 16; ++r) { oc[0][r] = 0.f; oc[1][r] = 0.f; }
#pragma unroll 1
        for (int kt = 0; kt < 2; ++kt) {
            f32x16 s0, s1;
            qk_scores<64>(lds, kt, qf, r32, hi, s0, s1);
#pragma unroll
            for (int r = 0; r < 16; ++r) { const int c0 = 64 * kt + 16 * hi + r, c1 = c0 + 32;
                s0[r] = ((c0 * 16 + 31 <= t) && (c0 < 127)) ? __builtin_amdgcn_exp2f(s0[r] * c2 - mx) : 0.f;
                s1[r] = ((c1 * 16 + 31 <= t) && (c1 < 127)) ? __builtin_amdgcn_exp2f(s1[r] * c2 - mx) : 0.f;
                ls += s0[r] + s1[r]; }
#pragma unroll
            for (int a = 0; a < 4; ++a) {
                { const int j1 = 16 * kt + 4 * hi + a; const float p3 = 0.5f * s0[4 * a + 3];
                  impA[(h * 64 + ql) * 33 + j1] = s0[4 * a] + s0[4 * a + 1] + s0[4 * a + 2] + p3; impB[(h * 64 + ql) * 33 + j1 + 1] = p3; }
                { const int j1 = 16 * kt + 8 + 4 * hi + a; const float p3 = 0.5f * s1[4 * a + 3];
                  impA[(h * 64 + ql) * 33 + j1] = s1[4 * a] + s1[4 * a + 1] + s1[4 * a + 2] + p3; if (j1 + 1 < 32) impB[(h * 64 + ql) * 33 + j1 + 1] = p3; }
            }
            pv_acc(lds, kt, r32, hi, s0, s1, oc);
        }
        ls += xchg32(ls);
        const float inv = ls > 0.f ? 1.f / ls : 0.f;
        if (hi == 0) impA[(h * 64 + ql) * 33 + 32] = inv;
#pragma unroll
        for (int r = 0; r < 16; ++r) { ot[0][r] = g0 * inv * oc[0][r]; ot[1][r] = g0 * inv * oc[1][r]; }
    }
    __syncthreads();
    {
        const int q = tid & 63, part = tid >> 6;
        LAS float* row = impA + q * 33;
        const float iv0 = impA[(0 * 64 + q) * 33 + 32], iv1 = impA[(1 * 64 + q) * 33 + 32], iv2 = impA[(2 * 64 + q) * 33 + 32], iv3 = impA[(3 * 64 + q) * 33 + 32];
        float xv[4];
#pragma unroll
        for (int jj = 0; jj < 4; ++jj) { const int j = 4 * part + jj;
            float x = iv0 * (impA[(0 * 64 + q) * 33 + j] + (j > 0 ? impB[(0 * 64 + q) * 33 + j] : 0.f));
            x += iv1 * (impA[(1 * 64 + q) * 33 + j] + (j > 0 ? impB[(1 * 64 + q) * 33 + j] : 0.f));
            x += iv2 * (impA[(2 * 64 + q) * 33 + j] + (j > 0 ? impB[(2 * 64 + q) * 33 + j] : 0.f));
            x += iv3 * (impA[(3 * 64 + q) * 33 + j] + (j > 0 ? impB[(3 * 64 + q) * 33 + j] : 0.f));
            if (j == 0 || j == tq || j == tq - 1) x = 1e4f;
            xv[jj] = (j <= tq) ? x : -3e38f; }
        LDS_WAIT();
#pragma unroll
        for (int jj = 0; jj < 4; ++jj) row[4 * part + jj] = xv[jj];
    }
    __syncthreads();
    {
        const int q = tid & 63, part = tid >> 6;
        const LAS float* row = impA + q * 33;
        float vj[4]; int rk[4];
#pragma unroll
        for (int jj = 0; jj < 4; ++jj) { vj[jj] = row[4 * part + jj]; rk[jj] = 0; }
#pragma unroll 8
        for (int j2 = 0; j2 < 32; ++j2) { const float v2 = row[j2];
#pragma unroll
            for (int jj = 0; jj < 4; ++jj) rk[jj] += (v2 > vj[jj] || (v2 == vj[jj] && j2 < 4 * part + jj)) ? 1 : 0; }
        unsigned bits = 0u;
#pragma unroll
        for (int jj = 0; jj < 4; ++jj) { const int jb = 4 * part + jj; if (rk[jj] < 8 && jb <= tq) bits |= 1u << jb; }
        if (bits) { atomicOr((unsigned*)selq_l + q, bits); atomicOr((unsigned*)selu_l, bits); }
    }
    __syncthreads();
    const unsigned selq = selq_l[ql]; const unsigned selu = selu_l[0];
    {
        PolSel ps; ps.zb = zb; ps.t = t; ps.hi = hi; ps.selq = selq; ps.c2 = c2;
        float m_run = -1e20f, l_run = 0.f; f32x16 o[2];
#pragma unroll
        for (int r = 0; r < 16; ++r) { o[0][r] = 0.f; o[1][r] = 0.f; }
        flash_run<64, PolSel>(lds, ps, selu, qf, m_run, l_run, o, tid);
        const float lt = l_run + xchg32(l_run); const float w = lt > 0.f ? g1 / lt : 0.f;
#pragma unroll
        for (int r = 0; r < 16; ++r) { ot[0][r] += w * o[0][r]; ot[1][r] += w * o[1][r]; }
    }
    {
        PolWin pw; pw.zb = zb; pw.t = t; pw.hi = hi; pw.w0 = tq * 64 + (wave & 1) * 32; pw.c2 = c2;
        float m_run = -1e20f, l_run = 0.f; f32x16 o[2];
#pragma unroll
        for (int r = 0; r < 16; ++r) { o[0][r] = 0.f; o[1][r] = 0.f; }
        const int lo = tq >= 8 ? tq - 8 : 0;
        const unsigned tmask = ((tq == 31) ? 0xffffffffu : ((1u << (tq + 1)) - 1u)) & ~((1u << lo) - 1u);
        flash_run<64, PolWin>(lds, pw, tmask, qf, m_run, l_run, o, tid);
        const float lt = l_run + xchg32(l_run); const float w = lt > 0.f ? g2 / lt : 0.f;
#pragma unroll
        for (int r = 0; r < 16; ++r) { ot[0][r] += w * o[0][r]; ot[1][r] += w * o[1][r]; }
    }
    store_o(O + (size_t)(b * SEQ + t) * DM + 256 + h * 64, ot, 1.f, hi);
}
}


__device__ __forceinline__ void row_bf16_sq(const float* xrow, bf16_t* orow, float* sqp, int lane) {
    const f32x4* xr = (const f32x4*)xrow + lane;
    f32x4 v[4]; float s = 0.f;
#pragma unroll
    for (int j = 0; j < 4; ++j) { v[j] = xr[64 * j]; s += (v[j].x * v[j].x + v[j].y * v[j].y) + (v[j].z * v[j].z + v[j].w * v[j].w); }
    s = wave_sum(s);
    unsigned long long* o8 = (unsigned long long*)orow + lane;
#pragma unroll
    for (int j = 0; j < 4; ++j) o8[64 * j] = (unsigned long long)pk2(v[j].x, v[j].y) | ((unsigned long long)pk2(v[j].z, v[j].w) << 32);
    if (lane == 0) *sqp = s;
}

__device__ __forceinline__ int att_unit_cost(int u) {
    const int ty = u >> 8, k = u & 255;
    if (ty == 0) return 10 * ((k & 7) + 1);
    if (ty == 1) return 0;
    const int tq1 = (k & 31) + 1;
    if (ty == 2) return 2 * tq1;
    return 2 * (6 + (tq1 < 14 ? tq1 : 14) + (tq1 < 9 ? tq1 : 9));
}
#define XB_TMO      128
#define XB_XCNT(j)  (256  + 64 * (j))
#define XB_XSUB(j)  (1280 + 64 * (j))
#define XB_XGEN(j)  (2304 + 64 * (j))
#define XB_TOP      3328
#define XB_TOPGEN   3392
#define XCD_BAR_WORDS 3456
#define XB_SPIN_CAP (1u << 18)
__device__ __forceinline__ unsigned xb_ld(unsigned* p)              { return __hip_atomic_load(p, __ATOMIC_RELAXED, __HIP_MEMORY_SCOPE_AGENT); }
__device__ __forceinline__ unsigned xb_add(unsigned* p, unsigned v) { return __hip_atomic_fetch_add(p, v, __ATOMIC_RELAXED, __HIP_MEMORY_SCOPE_AGENT); }
__device__ __forceinline__ unsigned xb_xcc_id() { return (unsigned)__builtin_amdgcn_s_getreg((3 << 11) | 20) & 0xFu; }
#define XB_SPIN(cond, bar) do { unsigned _sp = 0; while (cond) { __builtin_amdgcn_s_sleep(1); \
    if ((++_sp & 255u) == 0u) { if (xb_ld(&(bar)[XB_TMO])) break; if (_sp > XB_SPIN_CAP) { atomicAdd(&(bar)[XB_TMO], 1u); break; } } } } while (0)
struct XcdBarrier { unsigned* bar; unsigned x; volatile LAS unsigned* st; };
__device__ __forceinline__ XcdBarrier xcd_barrier_post(unsigned* bar, volatile LAS unsigned* st) {
    XcdBarrier b; b.bar = bar; b.x = xb_xcc_id(); b.st = st;
    if (threadIdx.x == 0) (void)xb_add(&bar[XB_XCNT(b.x)], 1u);
    return b;
}
__device__ __forceinline__ void xcd_barrier_complete(unsigned* bar, unsigned x, unsigned& nloc, unsigned& nx) {
    const unsigned G = gridDim.x * gridDim.y * gridDim.z;
    unsigned sum, cnt, mine, sp = 0u;
    for (;;) {
        sum = 0u; cnt = 0u; mine = 0u;
#pragma unroll
        for (unsigned j = 0; j < 16; ++j) { const unsigned c = xb_ld(&bar[XB_XCNT(j)]); sum += c; cnt += (c > 0u) ? 1u : 0u; mine = (j == x) ? c : mine; }
        if (sum == G) break;
        __builtin_amdgcn_s_sleep(1);
        if ((++sp & 255u) == 0u) { if (xb_ld(&bar[XB_TMO])) break; if (sp > XB_SPIN_CAP) { atomicAdd(&bar[XB_TMO], 1u); break; } }
    }
    nloc = mine > 0u ? mine : 1u; nx = cnt > 0u ? cnt : 1u;
}
__device__ __forceinline__ void xcd_barrier(const XcdBarrier& b) {
    asm volatile("s_waitcnt vmcnt(0)" ::: "memory");
    __syncthreads();
    if (threadIdx.x == 0) {
        unsigned* bar = b.bar;
        __builtin_amdgcn_s_waitcnt(0);
        unsigned nloc = b.st[0], nx = b.st[1];
        if (nloc == 0u) { xcd_barrier_complete(bar, b.x, nloc, nx); b.st[0] = nloc; b.st[1] = nx; }
        const unsigned old = xb_add(&bar[XB_XSUB(b.x)], 1u);
        const unsigned gen = old / nloc;
        if (old + 1u == (gen + 1u) * nloc) {
            __builtin_amdgcn_fence(__ATOMIC_RELEASE, "agent");
            asm volatile("s_waitcnt vmcnt(0)" ::: "memory");
            const unsigned og = xb_add(&bar[XB_TOP], 1u);
            const unsigned tg = og / nx;
            if (og + 1u == (tg + 1u) * nx) xb_add(&bar[XB_TOPGEN], 1u);
            else XB_SPIN(xb_ld(&bar[XB_TOPGEN]) == tg, bar);
            __builtin_amdgcn_fence(__ATOMIC_ACQUIRE, "agent");
            xb_add(&bar[XB_XGEN(b.x)], 1u);
            asm volatile("s_waitcnt vmcnt(0)" ::: "memory");
        } else {
            XB_SPIN(xb_ld(&bar[XB_XGEN(b.x)]) == gen, bar);
            __builtin_amdgcn_fence(__ATOMIC_ACQUIRE, "agent");
            asm volatile("s_waitcnt vmcnt(0)" ::: "memory");
        }
    }
    __syncthreads();
}
constexpr int LDS_XB_OFF = 131072 + 512;
constexpr size_t WS_BAR = 65536;
constexpr size_t WS_SQ = 131072;

#define CAS __attribute__((address_space(4)))
#define ARGS() (*({ const CAS Args* p_ = (const CAS Args*)__builtin_amdgcn_kernarg_segment_ptr(); asm volatile("" : "+s"(p_)); p_; }))
__global__ void __launch_bounds__(512, 2) fwd_kernel(Args a_unused) {
    extern __shared__ __attribute__((aligned(16))) unsigned char lds_raw[];
    LAS unsigned char* lds = (LAS unsigned char*)lds_raw;
    cg::grid_group grid = cg::this_grid();
    { volatile LAS unsigned* stw = (volatile LAS unsigned*)(lds + LDS_XB_OFF); if (threadIdx.x < 4) stw[threadIdx.x] = 0u; }
    __syncthreads();
    const XcdBarrier xbar = xcd_barrier_post((unsigned*)(ARGS().ws + WS_BAR), (volatile LAS unsigned*)(lds + LDS_XB_OFF));
    grid.sync();
#define GSYNC() xcd_barrier(xbar)
    const int G = gridDim.x, NGW = G * 8;
#define ws (ARGS().ws)
#define H ((bf16_t*)(ws + WS_H))
#define Z ((bf16_t*)(ws + WS_Z))
#define O ((bf16_t*)(ws + WS_O))
#define GATE ((bf16_t*)(ws + WS_GATE))
#define HID ((bf16_t*)(ws + WS_HID))

    for (int l = 0; l < DEPTH; ++l) {
        const float* xin = (l == 0) ? ARGS().x : ARGS().out;
        int tid = threadIdx.x; asm volatile("" : "+v"(tid));
        int bx = blockIdx.x; asm volatile("" : "+s"(bx));
        const int lane = tid & 63, wave = __builtin_amdgcn_readfirstlane(tid >> 6), gw = bx * 8 + wave;
        p0_weights(ARGS(), l, lds, gw, NGW, lane, wave, (G == 256) ? 0 : 2);
        if (l == 0 && gw < 1024) {
            const int cu = att_unit_cost(gw); int r = 0;
            for (int v = lane; v < 1024; v += 64) { const int cv = att_unit_cost(v); r += (cv > cu || (cv == cu && v < gw)) ? 1 : 0; }
            r = (int)wred_add((unsigned)r);
            if (lane == 0) ((unsigned short*)(ws + 16384))[r] = (unsigned short)gw;
        }
        if (l == 0) { float* SQ = (float*)(ws + WS_SQ); for (int m = gw; m < NTOK; m += NGW) row_bf16_sq(xin + (size_t)m * DM, H + (size_t)m * DM, SQ + m, lane); }
        GSYNC();
        { pg8::Gemm g{H, (const bf16_t*)(ws + WS_WZ), NTOK, ZW, DM, DM, DM}; pg8::StaticOrder S; S.init(NTOK, ZW, G, bx);
          pg8::EpiBf16<0> E{Z, ZW, ZW, (const float*)(ws + WS_SQ) + (size_t)(2 * l) * NTOK}; pg8::gemm_phase(lds, g, S, E); }
        if (G == 256 && bx >= 128) p0_weights(ARGS(), l, lds, (bx - 128) * 8 + wave, 128 * 8, lane, wave, 1);
        GSYNC();
        { bf16_t* KCC = (bf16_t*)(ws + WS_KCC); bf16_t* VCC = (bf16_t*)(ws + WS_VCC); float* FC = (float*)(ws + WS_FOXC); const CAS Args& a = ARGS();
          if (gw < 32) fox_scan(ARGS(), l, Z, FC, gw, lane);
          if (NTOK % (4 * NGW) == 0) { for (int m = gw; m < NTOK; m += 4 * NGW) prep_tokens<4>(a, l, Z, KCC, VCC, m, NGW, lane); }
          else { for (int m = gw; m < NTOK; m += NGW) prep_tokens<1>(a, l, Z, KCC, VCC, m, NGW, lane); } }
        GSYNC();
        { bf16_t* QKVM = (bf16_t*)(ws + WS_QKVM);
          pg8::Gemm g{Z, (const bf16_t*)(ws + WS_WMLA), NTOK, 1024, 384, ZW, 384}; pg8::StaticOrder S; S.init(NTOK, 1024, G, bx);
          pg8::EpiBf16<0> E{QKVM, 1024, 1024, nullptr}; pg8::gemm_phase(lds, g, S, E);
          { pg8::Gemm gk{(const bf16_t*)(ws + WS_KCC), (const bf16_t*)(ws + WS_WCMP), 1024, 256, 2048, 1024, 2048}; pg8::StaticOrder Sk; Sk.init(1024, 256, G, bx);
            pg8::EpiCmp Ek{(bf16_t*)(ws + WS_KCMP), (const float*)(ws + WS_CMPB)}; pg8::gemm_phase(lds, gk, Sk, Ek);
            pg8::Gemm gv{(const bf16_t*)(ws + WS_VCC), (const bf16_t*)(ws + WS_WCMP) + (size_t)256 * 2048, 1024, 256, 2048, 1024, 2048}; pg8::StaticOrder Sv; Sv.init(1024, 256, G, (bx + G - 4) % G);
            pg8::EpiCmp Ev{(bf16_t*)(ws + WS_VCMP), (const float*)(ws + WS_CMPB) + 64}; pg8::gemm_phase(lds, gv, Sv, Ev); }
          unsigned long long* SELM = (unsigned long long*)(ws + WS_SELM);
          { unsigned* qctr = (unsigned*)(ws + 8192) + (2 + l) * 64; LAS unsigned* qslot = (LAS unsigned*)(lds + 131072 + 768);
            const int nstat3 = G < 1280 ? G : 1280;
            for (int it = 0;; ++it) {
                int idx;
                if (it == 0) { idx = bx; if (idx >= nstat3) continue; }
                else {
                    __syncthreads();
                    if (tid == 0) qslot[0] = __hip_atomic_fetch_add(qctr, 1u, __ATOMIC_RELAXED, __HIP_MEMORY_SCOPE_AGENT);
                    __syncthreads();
                    idx = nstat3 + (int)qslot[0];
                }
                if (idx >= 1280) break;
                int tid_i = tid; asm volatile("" : "+v"(tid_i));
                if (idx >= 256) { const int k = idx - 256; att::dsa_index_unit(lds, Z, SELM, k & 7, 127 - (k >> 3), tid_i); }
                else { att::fox_unit(lds, Z, (const float*)(ws + WS_FOXC), O, (idx >> 2) & 7, idx & 3, 7 - (idx >> 5), tid_i); }
            } } }
        GSYNC();
        { const float* FC = (const float*)(ws + WS_FOXC); const bf16_t* QKVM = (const bf16_t*)(ws + WS_QKVM); const unsigned long long* SELM = (const unsigned long long*)(ws + WS_SELM);
          unsigned* qctr = (unsigned*)(ws + 8192) + l * 64;
          LAS unsigned* qslot = (LAS unsigned*)(lds + 131072 + 768);
          const int nstat4 = G < 768 ? G : 768;
          for (int it = 0;; ++it) {
              int idx;
              if (it == 0) { idx = bx; if (idx >= nstat4) continue; }
              else {
                  __syncthreads();
                  if (tid == 0) qslot[0] = __hip_atomic_fetch_add(qctr, 1u, __ATOMIC_RELAXED, __HIP_MEMORY_SCOPE_AGENT);
                  __syncthreads();
                  idx = nstat4 + (int)qslot[0];
              }
              if (idx >= 768) break;
              const int uid = (int)((const unsigned short*)(ws + 16384))[idx]; const int ty = uid >> 8, k = uid & 255;
              int tid_i = tid; asm volatile("" : "+v"(tid_i));
              if (ty == 0) att::mla_unit(lds, QKVM, Z, ARGS().pos, O, k >> 5, (k >> 3) & 3, k & 7, tid_i);
              else if (ty == 1) att::fox_unit(lds, Z, FC, O, k >> 5, (k >> 3) & 3, k & 7, tid_i);
              else if (ty == 2) att::dsa_unit(lds, Z, SELM, O, k >> 5, k & 31, tid_i);
              else att::nsa_unit(lds, Z, (const bf16_t*)(ws + WS_KCMP), (const bf16_t*)(ws + WS_VCMP), O, k >> 5, k & 31, tid_i);
          } }
        GSYNC();
        { pg8::Gemm g{H, (const bf16_t*)(ws + WS_WG), NTOK, 4096, DM, DM, DM};
          const int vcu = (G % 8 == 0) ? (bx % 8) * (G / 8) + bx / 8 : bx;
          pg8::FusedOrder S{G, vcu, (const char*)O, (const char*)(ws + WS_WBR2), (const char*)H, (const char*)(ws + WS_WG)};
          pg8::EpiFused E{GATE + (size_t)bx * 65536, Z, (const float*)(ws + WS_SQ) + (size_t)(2 * l) * NTOK}; pg8::gemm_phase(lds, g, S, E); }
        GSYNC();
        { pg8::Gemm g{Z, (const bf16_t*)(ws + WS_WOUT4), NTOK, DM, DM, DM, DM}; pg8::StaticOrder S; S.init(NTOK, DM, G, bx);
          pg8::EpiResid E{xin, ARGS().out, DM, H, (float*)(ws + WS_SQ) + (size_t)(2 * l + 1) * NTOK}; pg8::gemm_phase(lds, g, S, E); }
        GSYNC();
        { pg8::Gemm g{H, (const bf16_t*)(ws + WS_WUP), NTOK, DFF, DM, DM, DM}; pg8::StaticOrder S; S.init(NTOK, DFF, G, bx);
          pg8::EpiBf16<2> E{HID, DFF, DFF, (const float*)(ws + WS_SQ) + (size_t)(2 * l + 1) * NTOK}; pg8::gemm_phase(lds, g, S, E); }
        GSYNC();
        { pg8::Gemm g{HID, (const bf16_t*)(ws + WS_WDN), NTOK, DM, DFF, DFF, DFF}; pg8::StaticOrder S; S.init(NTOK, DM, G, bx);
          float* xo = ARGS().out; pg8::EpiResid E{xo, xo, DM, H, (float*)(ws + WS_SQ) + (size_t)(2 * l + 2) * NTOK}; pg8::gemm_phase(lds, g, S, E); }
        GSYNC();
    }
    { const int tid = threadIdx.x, lane = tid & 63, wave = __builtin_amdgcn_readfirstlane(tid >> 6), gw = blockIdx.x * 8 + wave;
      for (int m = gw; m < NTOK; m += NGW) rms_row_f32(ARGS().out + (size_t)m * DM, ARGS().final_g, lane); }
}

#undef ws
#undef H
#undef Z
#undef O
#undef GATE
#undef HID
extern "C" void kernel_launch(void* const* d_in, const int* in_sizes, int n_in, void* d_out, int out_size, void* d_ws, size_t ws_size, hipStream_t stream) {
    static int grid = 0;
    if (grid == 0) {
        int dev = 0, cus = 0, per_cu = 0;
        hipGetDevice(&dev);
        hipDeviceGetAttribute(&cus, hipDeviceAttributeMultiprocessorCount, dev);
        hipFuncSetAttribute((const void*)fwd_kernel, hipFuncAttributeMaxDynamicSharedMemorySize, LDS_BYTES);
        hipOccupancyMaxActiveBlocksPerMultiprocessor(&per_cu, (const void*)fwd_kernel, 512, LDS_BYTES);
        if (per_cu < 1) { fprintf(stderr, "occupancy query returned %d\n", per_cu); per_cu = 1; }
        grid = cus * 1;
        if (ws_size < WS_END) { fprintf(stderr, "workspace too small: %zu\n", ws_size); grid = -1; }
    }
    if (grid < 0) return;
    if (hipMemsetAsync(d_ws, 0, 131072 + 5 * 65536, stream) != hipSuccess) { fprintf(stderr, "memset failed\n"); return; }
    Args a{};
    a.x = (const float*)d_in[0]; a.pos = (const int*)d_in[1]; a.norm1_g = (const float*)d_in[2]; a.w_in = (const float*)d_in[3];
    a.mla_qg = (const float*)d_in[4]; a.mla_wuq = (const float*)d_in[5]; a.mla_kvg = (const float*)d_in[6]; a.mla_wukv = (const float*)d_in[7];
    a.cmp_pe = (const float*)d_in[8]; a.cmp_w = (const float*)d_in[9]; a.fox_fb = (const float*)d_in[10]; a.w_branch = (const float*)d_in[11];
    a.w_out = (const float*)d_in[12]; a.norm2_g = (const float*)d_in[13]; a.w_up = (const float*)d_in[14]; a.w_down = (const float*)d_in[15]; a.final_g = (const float*)d_in[16];
    a.out = (float*)d_out; a.ws = (unsigned char*)d_ws;
    void* args[] = {&a};
    hipError_t e = hipLaunchCooperativeKernel((const void*)fwd_kernel, dim3(grid), dim3(512), args, LDS_BYTES, stream);
    if (e != hipSuccess) fprintf(stderr, "cooperative launch failed: %s (grid %d)\n", hipGetErrorString(e), grid);
}
```
